# Optimizing an MI355X kernel written in HIP

```python
import jax, jax.numpy as jnp
from jax import lax
import numpy as np

D_MODEL = 1024
BATCH = 2
SEQ = 16384
DEPTH = 2

SB_HEADS = 4
SB_HEAD_DIM = 64
Q_BLOCK = 128
RET_HEADS = 4
RET_QK_DIM = 64
RET_V_DIM = 128
RET_CHUNK = 128
ROPE_BASE = 10000.0
POOL_GROUPS = 4
POOL_GROUP_DIM = 64
POOL_WINDOWS = (2, 4, 8, 16)
N_BRANCHES = 3
D_FF = 2816
EPS = 1e-6

SB_W = SB_HEADS * SB_HEAD_DIM
RET_QK_W = RET_HEADS * RET_QK_DIM
RET_V_W = RET_HEADS * RET_V_DIM
POOL_W = POOL_GROUPS * POOL_GROUP_DIM
SPLITS = (SB_W, SB_W, SB_W, RET_QK_W, RET_QK_W, RET_V_W, RET_V_W, POOL_W, N_BRANCHES * D_MODEL)
D_IN = SB_W * 3 + RET_QK_W * 2 + RET_V_W * 2 + POOL_W + N_BRANCHES * D_MODEL

kernel_name = "hybrid_sb_retention_pool_macaron"


def rmsnorm(x, g):
    xf = x.astype(jnp.float32)
    y = xf * lax.rsqrt(jnp.mean(xf * xf, axis=-1, keepdims=True) + EPS)
    return (y * g.astype(jnp.float32)).astype(x.dtype)


def swiglu_half(h, w1, w3, w2):
    return 0.5 * ((jax.nn.silu(h @ w1) * (h @ w3)) @ w2)


def stick_breaking_attention(q, k, v):
    B, S, H, dh = q.shape
    qf = (q.astype(jnp.float32) * (dh ** -0.5)).transpose(0, 2, 1, 3)
    kf = k.astype(jnp.float32).transpose(0, 2, 1, 3)
    vf = v.astype(jnp.float32).transpose(0, 2, 1, 3)
    nb = S // Q_BLOCK
    q_blocks = qf.reshape(B, H, nb, Q_BLOCK, dh).transpose(2, 0, 1, 3, 4)
    key_pos = jnp.arange(S)

    def block(args):
        qb, start = args
        z = jnp.einsum('bhqd,bhkd->bhqk', qb, kf)
        q_pos = start + jnp.arange(Q_BLOCK)
        mask = key_pos[None, :] < q_pos[:, None]
        log_beta = jax.nn.log_sigmoid(z)
        log_fail = jnp.where(mask, log_beta - z, 0.0)
        after = lax.cumsum(log_fail, axis=3, reverse=True) - log_fail
        w = jnp.where(mask, jnp.exp(log_beta + after), 0.0)
        return jnp.einsum('bhqk,bhkd->bhqd', w, vf)

    out = lax.map(block, (q_blocks, jnp.arange(nb) * Q_BLOCK))
    return out.transpose(1, 0, 3, 2, 4).reshape(B, S, H * dh)


def rotary(x, cos, sin):
    half = x.shape[-1] // 2
    x1, x2 = x[..., :half], x[..., half:]
    c = cos[None, :, None, :]
    s = sin[None, :, None, :]
    return jnp.concatenate([x1 * c - x2 * s, x2 * c + x1 * s], axis=-1)


def retention(q, k, v, g):
    B, S, H, dk = q.shape
    dv = v.shape[-1]
    half = dk // 2
    pos = jnp.arange(S, dtype=jnp.float32)
    inv_freq = ROPE_BASE ** (-jnp.arange(half, dtype=jnp.float32) / half)
    ang = pos[:, None] * inv_freq[None, :]
    cos, sin = jnp.cos(ang), jnp.sin(ang)
    qf = rotary(q.astype(jnp.float32), cos, sin)
    kf = rotary(k.astype(jnp.float32), cos, sin) * (dk ** -0.5)
    vf = v.astype(jnp.float32)
    log_gamma = jnp.log(1.0 - 2.0 ** (-5.0 - jnp.arange(H, dtype=jnp.float32)))

    C = RET_CHUNK
    N = S // C
    qc = qf.reshape(B, N, C, H, dk)
    kc = kf.reshape(B, N, C, H, dk)
    vc = vf.reshape(B, N, C, H, dv)
    idx = jnp.arange(C, dtype=jnp.float32)
    diff = idx[:, None] - idx[None, :]
    causal = diff >= 0
    decay = jnp.where(causal[None], jnp.exp(jnp.where(causal, diff, 0.0)[None] * log_gamma[:, None, None]), 0.0)
    scores = jnp.einsum('bnihd,bnjhd->bnhij', qc, kc) * decay
    intra = jnp.einsum('bnhij,bnjhe->bnihe', scores, vc)

    k_decay = jnp.exp((C - 1 - idx)[:, None] * log_gamma[None, :])
    kv = jnp.einsum('bnjhd,bnjhe->nbhde', kc * k_decay[:, :, None], vc)
    chunk_decay = jnp.exp(C * log_gamma)[None, :, None, None]

    def step(state, kv_n):
        return chunk_decay * state + kv_n, state

    _, states = lax.scan(step, jnp.zeros((B, H, dk, dv), jnp.float32), kv)
    q_decay = jnp.exp((idx + 1)[:, None] * log_gamma[None, :])
    cross = jnp.einsum('bnihd,nbhde->bnihe', qc * q_decay[:, :, None], states)

    y = (intra + cross).reshape(B, S, H, dv)
    y = y * lax.rsqrt(jnp.mean(y * y, axis=-1, keepdims=True) + EPS)
    return y.reshape(B, S, H * dv) * jax.nn.silu(g.astype(jnp.float32))


def pool_mixer(u, w_pool, pool_scale):
    B, S, _ = u.shape
    uf = u.astype(jnp.float32).reshape(B, S, POOL_GROUPS, POOL_GROUP_DIM)
    cs = jnp.concatenate([jnp.zeros((B, 1, POOL_GROUPS, POOL_GROUP_DIM), jnp.float32),
                          jnp.cumsum(uf, axis=1)], axis=1)
    t = jnp.arange(S)
    win = jnp.array(POOL_WINDOWS)
    lo = jnp.maximum(t[:, None] + 1 - win[None, :], 0)
    count = (t[:, None] + 1 - lo).astype(jnp.float32)
    cs_lo = cs[:, lo, jnp.arange(POOL_GROUPS)[None, :], :]
    mean = (cs[:, 1:] - cs_lo) / count[None, :, :, None]
    y = jnp.einsum('bsgc,gce->bsge', mean - uf, w_pool.astype(jnp.float32))
    return y.reshape(B, S, POOL_W) * pool_scale.astype(jnp.float32)


def setup_inputs(seed: int = 0) -> dict:
    key = jax.random.key(seed)
    ks = jax.random.split(key, 20)

    def w(k, shape, fan_in):
        return jax.random.normal(k, shape, jnp.float32) * (fan_in ** -0.5)

    def gain(k, shape):
        return 1.0 + 0.02 * jax.random.normal(k, shape, jnp.float32)

    return {
        "x": jax.random.normal(ks[0], (BATCH, SEQ, D_MODEL), jnp.float32),
        "g_ffn1": gain(ks[1], (DEPTH, D_MODEL)),
        "w1_ffn1": w(ks[2], (DEPTH, D_MODEL, D_FF), D_MODEL),
        "w3_ffn1": w(ks[3], (DEPTH, D_MODEL, D_FF), D_MODEL),
        "w2_ffn1": w(ks[4], (DEPTH, D_FF, D_MODEL), D_FF),
        "g_mix": gain(ks[5], (DEPTH, D_MODEL)),
        "w_in": w(ks[6], (DEPTH, D_MODEL, D_IN), D_MODEL),
        "w_branch_sb": w(ks[7], (DEPTH, SB_W, D_MODEL), SB_W),
        "w_branch_ret": w(ks[8], (DEPTH, RET_V_W, D_MODEL), RET_V_W),
        "w_branch_pool": w(ks[9], (DEPTH, POOL_W, D_MODEL), POOL_W),
        "w_pool": w(ks[10], (DEPTH, POOL_GROUPS, POOL_GROUP_DIM, POOL_GROUP_DIM), POOL_GROUP_DIM),
        "pool_scale": gain(ks[11], (DEPTH, POOL_W)),
        "w_out": w(ks[12], (DEPTH, D_MODEL, D_MODEL), D_MODEL),
        "g_ffn2": gain(ks[13], (DEPTH, D_MODEL)),
        "w1_ffn2": w(ks[14], (DEPTH, D_MODEL, D_FF), D_MODEL),
        "w3_ffn2": w(ks[15], (DEPTH, D_MODEL, D_FF), D_MODEL),
        "w2_ffn2": w(ks[16], (DEPTH, D_FF, D_MODEL), D_FF),
        "g_final": gain(ks[17], (D_MODEL,)),
    }


def reference(x, g_ffn1, w1_ffn1, w3_ffn1, w2_ffn1, g_mix, w_in, w_branch_sb, w_branch_ret,
              w_branch_pool, w_pool, pool_scale, w_out, g_ffn2, w1_ffn2, w3_ffn2, w2_ffn2, g_final):
    B, S, D = x.shape
    split_points = [int(p) for p in np.cumsum(SPLITS)[:-1]]
    for l in range(DEPTH):
        x = x + swiglu_half(rmsnorm(x, g_ffn1[l]), w1_ffn1[l], w3_ffn1[l], w2_ffn1[l])

        h = rmsnorm(x, g_mix[l])
        proj = h @ w_in[l]
        q_sb, k_sb, v_sb, q_r, k_r, v_r, g_r, u_p, gate = jnp.split(proj, split_points, axis=-1)
        y_sb = stick_breaking_attention(q_sb.reshape(B, S, SB_HEADS, SB_HEAD_DIM),
                                        k_sb.reshape(B, S, SB_HEADS, SB_HEAD_DIM),
                                        v_sb.reshape(B, S, SB_HEADS, SB_HEAD_DIM))
        y_ret = retention(q_r.reshape(B, S, RET_HEADS, RET_QK_DIM),
                          k_r.reshape(B, S, RET_HEADS, RET_QK_DIM),
                          v_r.reshape(B, S, RET_HEADS, RET_V_DIM), g_r)
        y_pool = pool_mixer(u_p, w_pool[l], pool_scale[l])

        gates = jax.nn.sigmoid(gate.astype(jnp.float32)).reshape(B, S, N_BRANCHES, D)
        merged = (gates[:, :, 0] * (y_sb @ w_branch_sb[l].astype(jnp.float32))
                  + gates[:, :, 1] * (y_ret @ w_branch_ret[l].astype(jnp.float32))
                  + gates[:, :, 2] * (y_pool @ w_branch_pool[l].astype(jnp.float32)))
        x = x + merged.astype(x.dtype) @ w_out[l]

        x = x + swiglu_half(rmsnorm(x, g_ffn2[l]), w1_ffn2[l], w3_ffn2[l], w2_ffn2[l])
    return rmsnorm(x, g_final)
```

```cpp
#include <hip/hip_runtime.h>
#include <cstdio>
#include <cstdint>

namespace pg8 {
#define PG8_LAS __attribute__((address_space(3)))
typedef unsigned short bf16_t;
typedef short bf16x8 __attribute__((ext_vector_type(8)));
typedef float f32x4 __attribute__((ext_vector_type(4)));
typedef unsigned u32x4 __attribute__((ext_vector_type(4)));
constexpr int BM = 256, BK = 64, HALF = 128, HTB = HALF * BK * 2  , STAGE_BYTES = 8 * HTB, NXCD = 8, WGM = 8;

__host__ __device__ __forceinline__ int lds_byte(int r, int c) { const int st = (r >> 4) * 2 + (c >> 5), rr = r & 15, cc = c & 31, ob = rr * 64 + cc * 2; return st * 1024 + (ob ^ (((ob >> 9) & 1) << 5)); }
__host__ __device__ __forceinline__ void stage_rc(int b, int& R, int& C) { const int st = b / 1024, sb = b % 1024, swz = sb ^ (((sb >> 9) & 1) << 5); R = (st >> 1) * 16 + swz / 64; C = (st & 1) * 32 + (swz % 64) / 2; }
__host__ __device__ __forceinline__ int perm32(int rho) { const int n = rho >> 4, i = rho & 15; return 8 * (i >> 2) + 4 * n + (i & 3); }

struct Unit { int pm, pn; };
struct Gemm { const bf16_t* A; const bf16_t* Bt; int M, N, K; };

struct StaticOrder {
    int nM, nN, nwg, G, c;
    __host__ __device__ void init(int M, int N, int G_, int c_) { nM = M / BM; nN = N / BM; nwg = nM * nN; G = G_; c = c_; }
    __host__ __device__ bool next(int i, Unit& u) const {
        const long L = (long)i * G + c; if (L >= nwg) return false;
        int wgid = (int)L; { const int q = nwg / NXCD, r = nwg % NXCD, xcd = wgid % NXCD, off = wgid / NXCD; wgid = (xcd < r ? xcd * (q + 1) : r * (q + 1) + (xcd - r) * q) + off; }
        const int nig = WGM * nN, gid = wgid / nig, fm = gid * WGM, gsz = (nM - fm) < WGM ? (nM - fm) : WGM;
        u.pm = fm + ((wgid % nig) % gsz); u.pn = (wgid % nig) / gsz; return true;
    }
    __device__ __forceinline__ void a_ready(const Unit&) const {}
    __device__ __forceinline__ void done(const Unit&) const {}
};


typedef float f32x2 __attribute__((ext_vector_type(2)));
typedef __bf16 bf16x2_t __attribute__((ext_vector_type(2)));
typedef unsigned u32x2 __attribute__((ext_vector_type(2)));
typedef __amdgpu_buffer_rsrc_t rsrc_t;
__device__ __forceinline__ rsrc_t mkrsrc(const void* p, unsigned bytes) { return __builtin_amdgcn_make_buffer_rsrc((void*)p, 0, (int)bytes, 0x00020000); }
__device__ __forceinline__ u32x4 bl128(rsrc_t r, int voff, int soff) { return __builtin_amdgcn_raw_buffer_load_b128(r, voff, soff, 0); }
__device__ __forceinline__ f32x4 bl128f(rsrc_t r, int voff, int soff) { return __builtin_bit_cast(f32x4, __builtin_amdgcn_raw_buffer_load_b128(r, voff, soff, 0)); }
__device__ __forceinline__ void bs128(rsrc_t r, u32x4 v, int voff, int soff) { __builtin_amdgcn_raw_buffer_store_b128(v, r, voff, soff, 0); }
__device__ __forceinline__ void bs64(rsrc_t r, u32x2 v, int voff, int soff) { __builtin_amdgcn_raw_buffer_store_b64(v, r, voff, soff, 0); }
__device__ __forceinline__ int vadd(int base, int c) { int r = base + c; asm volatile("" : "+v"(r)); return r; }
__device__ __forceinline__ unsigned pk_bf16(float lo, float hi) { f32x2 v = {lo, hi}; bf16x2_t b = __builtin_convertvector(v, bf16x2_t); return __builtin_bit_cast(unsigned, b); }
__device__ __forceinline__ float bf_lo(unsigned w) { return __builtin_bit_cast(float, w << 16); }
__device__ __forceinline__ float bf_hi(unsigned w) { return __builtin_bit_cast(float, w & 0xffff0000u); }
#ifndef MK_SCALAR_RS
#define MK_SCALAR_RS 0
#endif
constexpr float LOG2E = 1.4426950408889634f;
__device__ __forceinline__ float fmul1(float a, float b) { float r; asm("v_mul_f32 %0, %1, %2" : "=v"(r) : "v"(a), "v"(b)); return r; }
constexpr unsigned MROWS = 32768;
__device__ __forceinline__ float sigmoid_f(float v) { return __builtin_amdgcn_rcpf(1.0f + __builtin_amdgcn_exp2f(-v * LOG2E)); }
__device__ __forceinline__ float rs_of(const f32x4 s) { return __builtin_amdgcn_rsqf(((s[0] + s[1]) + (s[2] + s[3])) * (1.0f / 1024.0f) + 1e-6f); }
__device__ __forceinline__ float row_rs(const float* ssq, int row) { return rs_of(*(const f32x4*)(ssq + (size_t)row * 4)); }
__device__ __forceinline__ void load_rs8(const float* ssq, int row0, float (&rs)[2][4]) {
    const rsrc_t r = mkrsrc(ssq, MROWS * 16u); f32x4 s[2][4];
#pragma unroll
    for (int ai = 0; ai < 2; ++ai)
#pragma unroll
        for (int m = 0; m < 4; ++m) s[ai][m] = bl128f(r, row0 * 16 + (ai * HALF + m * 16) * 16, 0);
#pragma unroll
    for (int ai = 0; ai < 2; ++ai)
#pragma unroll
        for (int m = 0; m < 4; ++m) rs[ai][m] = rs_of(s[ai][m]);
}
__device__ __forceinline__ void rs8_table(const float* ssq, PG8_LAS float* rst, const Unit& u, int wr, int fr, bool newpm, float (&rs)[2][4]) {
    if (newpm) {
        if (threadIdx.x < 256) rst[threadIdx.x] = rs_of(*(const f32x4*)(ssq + (size_t)(u.pm * BM + (int)threadIdx.x) * 4));
        asm volatile("s_waitcnt lgkmcnt(0)" ::: "memory"); __builtin_amdgcn_s_barrier(); asm volatile("" ::: "memory");
    }
#pragma unroll
    for (int ai = 0; ai < 2; ++ai)
#pragma unroll
        for (int m = 0; m < 4; ++m) rs[ai][m] = rst[ai * HALF + wr * 64 + m * 16 + fr];
}
__device__ __forceinline__ float l2gamma(int h) { return h == 0 ? -0.04580368961312479f : h == 1 ? -0.02272007650008353f : h == 2 ? -0.011315313227834146f : -0.005646563141142063f; }

__device__ __forceinline__ u32x4 ror8(u32x4 v) { u32x4 r;
#pragma unroll
    for (int i = 0; i < 4; ++i) r[i] = (unsigned)__builtin_amdgcn_mov_dpp((int)v[i], 0x128, 0xf, 0xf, false);
    return r; }
__device__ __forceinline__ u32x4 sel4(bool c, u32x4 a, u32x4 b) { return (u32x4){c ? a[0] : b[0], c ? a[1] : b[1], c ? a[2] : b[2], c ? a[3] : b[3]}; }
__device__ __forceinline__ void line_pack(bool lo, u32x4 p0, u32x4 p1, u32x4& a, u32x4& b) { const u32x4 r1 = ror8(p1); a = sel4(lo, p0, r1); b = sel4(lo, r1, p0); }
__device__ __forceinline__ void line_unpack(bool lo, u32x4 a, u32x4 b, u32x4& p0, u32x4& p1) { p0 = sel4(lo, a, b); p1 = ror8(sel4(lo, b, a)); }

template <int MODE> struct EpiUpT {
    static constexpr bool PERM = true, AFTER_DRAIN = false, HAS_MID = false; static constexpr int MID0 = -1, MID1 = -1, NST = 8;
    bf16_t* O; const float* ssq; PG8_LAS float* rst;
    __device__ __forceinline__ void mid(f32x4 (&)[2][2][4][2], const Unit&, int, int, int, int, int) const {}
    __device__ __forceinline__ void operator()(const f32x4 (&acc)[2][2][4][2], const Unit& u, int wr, int wc, int fr, int fq, bool newpm) const {
        const int row0 = u.pm * BM + wr * 64 + fr, col0 = u.pn * 128 + wc * 32 + 8 * fq;
        float rs[2][4]; rs8_table(ssq, rst, u, wr, fr, newpm, rs);
        const rsrc_t ro = mkrsrc(O, MROWS * 2816u * 2u);
        const int vo = ((((u.pm * 44 + 2 * u.pn + (wc >> 1)) * 2 + (wc & 1)) * 256 + wr * 64 + fr) * 32 + 8 * fq) * 2;
#pragma unroll
        for (int ai = 0; ai < 2; ++ai)
#pragma unroll
            for (int m = 0; m < 4; ++m) {
                unsigned w[4];
#pragma unroll
                for (int n = 0; n < 2; ++n) { const f32x4 ag = acc[ai][0][m][n], gu = ag * acc[ai][1][m][n]; const float c1 = rs[ai][m] * -LOG2E, c2 = rs[ai][m] * rs[ai][m]; float o[4];
#pragma unroll
                    for (int j = 0; j < 4; ++j) o[j] = (MODE == 2) ? gu[j] : gu[j] * (c2 * __builtin_amdgcn_rcpf(1.0f + __builtin_amdgcn_exp2f(ag[j] * c1)));
                    w[2 * n] = pk_bf16(o[0], o[1]); w[2 * n + 1] = pk_bf16(o[2], o[3]); }
                if (MODE == 1) asm volatile("" :: "v"(w[0]), "v"(w[1]), "v"(w[2]), "v"(w[3])); else bs128(ro, (u32x4){w[0], w[1], w[2], w[3]}, vadd(vo, (ai * HALF + m * 16) * 32 * 2), 0);
            }
    }
};
typedef EpiUpT<0> EpiUp;

template <bool SRC_F32> struct EpiResid {
    static constexpr bool PERM = true, AFTER_DRAIN = false, HAS_MID = false; static constexpr int MID0 = -1, MID1 = -1, NST = 16;
    const void* Xs; bf16_t* XB; float* ssq; PG8_LAS float* P;
    __device__ __forceinline__ void mid(f32x4 (&)[2][2][4][2], const Unit&, int, int, int, int, int) const {}
    __device__ __forceinline__ void operator()(const f32x4 (&acc)[2][2][4][2], const Unit& u, int wr, int wc, int fr, int fq, bool newpm) const {
        const int rl0 = wr * 64 + fr, colw = u.pn * BM + wc * 64 + 8 * fq;
        const bool lo = fr < 8;
        const rsrc_t rs_ = mkrsrc(Xs, MROWS * 1024u * (SRC_F32 ? 4u : 2u)), rb = mkrsrc(XB, MROWS * 1024u * 2u);
        const int rowb = u.pm * BM + wr * 64;
        const int vA = ((rowb + (lo ? fr : fr - 8)) * 1024 + colw + (lo ? 0 : 32)) * 2, vB = ((rowb + (lo ? fr + 8 : fr)) * 1024 + colw + (lo ? 32 : 0)) * 2;
        const int vs = ((rowb + fr) * 1024 + colw) * 4;
#pragma unroll
        for (int ai = 0; ai < 2; ++ai) {
            u32x4 xv[4][2][SRC_F32 ? 2 : 1];
#pragma unroll
            for (int m = 0; m < 4; ++m) { const int ro = (ai * HALF + m * 16) * 1024;
                if (SRC_F32) { const int vr = vadd(vs, ro * 4);
#pragma unroll
                    for (int bj = 0; bj < 2; ++bj) { xv[m][bj][0] = bl128(rs_, vr + bj * 128, 0); xv[m][bj][SRC_F32 ? 1 : 0] = bl128(rs_, vr + bj * 128 + 16, 0); } }
                else { xv[m][0][0] = bl128(rs_, vadd(vA, ro * 2), 0); xv[m][1][0] = bl128(rs_, vadd(vB, ro * 2), 0); } }
#pragma unroll
            for (int m = 0; m < 4; ++m) { float ss = 0.f; const int ro = (ai * HALF + m * 16) * 1024; u32x4 pk[2];
                u32x4 x0, x1; if (!SRC_F32) line_unpack(lo, xv[m][0][0], xv[m][1][0], x0, x1);
#pragma unroll
                for (int bj = 0; bj < 2; ++bj) { f32x4 v0, v1;
                    if (SRC_F32) { v0 = __builtin_bit_cast(f32x4, xv[m][bj][0]); v1 = __builtin_bit_cast(f32x4, xv[m][bj][SRC_F32 ? 1 : 0]); }
                    else { const u32x4 x = bj ? x1 : x0; v0 = (f32x4){bf_lo(x[0]), bf_hi(x[0]), bf_lo(x[1]), bf_hi(x[1])}; v1 = (f32x4){bf_lo(x[2]), bf_hi(x[2]), bf_lo(x[3]), bf_hi(x[3])}; }
                    v0 = v0 + acc[ai][bj][m][0]; v1 = v1 + acc[ai][bj][m][1];
                    pk[bj] = (u32x4){pk_bf16(v0[0], v0[1]), pk_bf16(v0[2], v0[3]), pk_bf16(v1[0], v1[1]), pk_bf16(v1[2], v1[3])};
                    ss += ((v0[0] * v0[0] + v0[1] * v0[1]) + (v0[2] * v0[2] + v0[3] * v0[3])) + ((v1[0] * v1[0] + v1[1] * v1[1]) + (v1[2] * v1[2] + v1[3] * v1[3])); }
                { u32x4 a, b; line_pack(lo, pk[0], pk[1], a, b); bs128(rb, a, vadd(vA, ro * 2), 0); bs128(rb, b, vadd(vB, ro * 2), 0); }
                ss += __shfl_xor(ss, 16); ss += __shfl_xor(ss, 32);
                if (fq == 0) P[(rl0 + ai * HALF + m * 16) * 4 + wc] = ss; }
            asm volatile("" ::: "memory");
        }
        asm volatile("s_waitcnt lgkmcnt(0)" ::: "memory"); __builtin_amdgcn_s_barrier(); asm volatile("" ::: "memory");
        if (threadIdx.x < 256) { const f32x4 p = *(const PG8_LAS f32x4*)(P + threadIdx.x * 4); ssq[(size_t)(u.pm * BM + (int)threadIdx.x) * 4 + u.pn] = (p[0] + p[1]) + (p[2] + p[3]); }
    }
};

template <int PM> __device__ __forceinline__ void st128(rsrc_t r, u32x4 v, int voff, int soff) { if (PM >= 1) asm volatile("" :: "v"(v)); else bs128(r, v, voff, soff); }
template <int PM> struct EpiInProjT {
    static constexpr bool PERM = true, AFTER_DRAIN = false, HAS_MID = false; static constexpr int MID0 = -1, MID1 = -1, NST = 8;
    bf16_t* PA; bf16_t* PG; const float* ssq; const float* rope; PG8_LAS float* rst;
    __device__ __forceinline__ void mid(f32x4 (&)[2][2][4][2], const Unit&, int, int, int, int, int) const {}
    template <int MODE> __device__ __forceinline__ void blocked(const f32x4 (&acc)[2][2][4][2], const rsrc_t rd, int vo, int s_ai, int s_m, int s_bj) const {
#pragma unroll
        for (int ai = 0; ai < 2; ++ai)
#pragma unroll
            for (int m = 0; m < 4; ++m)
#pragma unroll
                for (int bj = 0; bj < 2; ++bj) { unsigned w[4]; float v[8];
#pragma unroll
                    for (int i = 0; i < 8; ++i) v[i] = acc[ai][bj][m][i >> 2][i & 3];
                    if (MODE == 1) {
                        float t[8];
#pragma unroll
                        for (int i = 0; i < 8; ++i) t[i] = v[i] * -LOG2E;
                        __builtin_amdgcn_sched_barrier(0);
#pragma unroll
                        for (int i = 0; i < 8; ++i) t[i] = __builtin_amdgcn_exp2f(t[i]);
                        __builtin_amdgcn_sched_barrier(0);
#pragma unroll
                        for (int i = 0; i < 8; ++i) t[i] = 1.0f + t[i];
                        __builtin_amdgcn_sched_barrier(0);
#pragma unroll
                        for (int i = 0; i < 8; ++i) t[i] = __builtin_amdgcn_rcpf(t[i]);
                        __builtin_amdgcn_sched_barrier(0);
#pragma unroll
                        for (int i = 0; i < 8; ++i) v[i] = v[i] * t[i];
                    }
#pragma unroll
                    for (int q = 0; q < 4; ++q) w[q] = pk_bf16(v[2 * q], v[2 * q + 1]);
                    st128<PM>(rd, (u32x4){w[0], w[1], w[2], w[3]}, vadd(vo, (ai * s_ai + m * s_m + bj * s_bj) * 2), 0); }
    }
    __device__ __forceinline__ void operator()(f32x4 (&acc)[2][2][4][2], const Unit& u, int wr, int wc, int fr, int fq, bool newpm) const {
        const int row0 = u.pm * BM + wr * 64 + fr, pn = u.pn;
        { float rs[2][4]; rs8_table(ssq, rst, u, wr, fr, newpm, rs);
#pragma unroll
          for (int ai = 0; ai < 2; ++ai)
#pragma unroll
              for (int m = 0; m < 4; ++m)
#pragma unroll
                  for (int bj = 0; bj < 2; ++bj)
#pragma unroll
                      for (int n = 0; n < 2; ++n) {
#if MK_SCALAR_RS
#pragma unroll
                          for (int j = 0; j < 4; ++j) acc[ai][bj][m][n][j] = fmul1(acc[ai][bj][m][n][j], rs[ai][m]);
#else
                          acc[ai][bj][m][n] = acc[ai][bj][m][n] * rs[ai][m];
#endif
                      }
          asm volatile("" : "+v"(acc[0][0][0][0]), "+v"(acc[1][1][3][1])); }
        const rsrc_t ra = mkrsrc(PA, MROWS * 2560u * 2u);
        constexpr int MR = 32768 * 256;
        if (PM == 2 && pn < 10) return; if (PM == 3 && pn != 3 && pn != 4) return; if (PM == 4 && (pn == 3 || pn == 4 || pn >= 10)) return;
        if (pn == 3 || pn == 4) {
            const float sl2g = (pn == 3 ? 1.f : -1.f) * l2gamma(wc);
            const rsrc_t rr = mkrsrc(rope, 16384u * 32u * 8u);
            const int vr = (row0 & 16383) * 256 + fq * 16;
            const int vo = (pn * MR + ((u.pm * 8 + wc) * 2) * 4096 + (wr * 64 + fr) * 32 + 8 * fq) * 2;
#pragma unroll
            for (int ai = 0; ai < 2; ++ai) {
                f32x4 cs[4][4];
#pragma unroll
                for (int m = 0; m < 4; ++m)
#pragma unroll
                    for (int q = 0; q < 4; ++q) cs[m][q] = bl128f(rr, vadd(vr, (ai * HALF + m * 16) * 256) + q * 64, 0);
#pragma unroll
                for (int m = 0; m < 4; ++m) {
                    const int rowi = (row0 + ai * HALF + m * 16) & 127;
                    const float dec = __builtin_amdgcn_exp2f(sl2g * (float)rowi);
                    unsigned w1[4], w2[4];
#pragma unroll
                    for (int q = 0; q < 4; ++q) { const f32x4 c = cs[m][q];
                        const int n = q >> 1, j = (q & 1) * 2;
                        const float xa0 = acc[ai][0][m][n][j], xa1 = acc[ai][0][m][n][j + 1], xb0 = acc[ai][1][m][n][j], xb1 = acc[ai][1][m][n][j + 1];
                        w1[q] = pk_bf16((xa0 * c[0] - xb0 * c[1]) * dec, (xa1 * c[2] - xb1 * c[3]) * dec);
                        w2[q] = pk_bf16((xb0 * c[0] + xa0 * c[1]) * dec, (xb1 * c[2] + xa1 * c[3]) * dec); }
                    { const int vs = vadd(vo, (ai * 32768 + m * 512) * 2); st128<PM>(ra, (u32x4){w1[0], w1[1], w1[2], w1[3]}, vs, 0); st128<PM>(ra, (u32x4){w2[0], w2[1], w2[2], w2[3]}, vadd(vs, 4096 * 2), 0); }
                }
                asm volatile("" ::: "memory");
            }
        } else if (pn >= 10) {
            const rsrc_t rg = mkrsrc(PG, MROWS * 3072u);
            const int vb = (u.pm * 12 + (pn - 10)) * 65536 + ((wr * 4 + wc) * 64 + fq * 16 + fr) * 16;
#pragma unroll
            for (int ai = 0; ai < 2; ++ai)
#pragma unroll
                for (int m = 0; m < 4; ++m) { unsigned w[4];
#pragma unroll
                    for (int bj = 0; bj < 2; ++bj) {
                        float t[8];
#pragma unroll
                        for (int i = 0; i < 8; ++i) t[i] = __builtin_amdgcn_fmed3f(acc[ai][bj][m][i >> 2][i & 3], -200.f, 7.934823f);
                        __builtin_amdgcn_sched_barrier(0);
#pragma unroll
                        for (int i = 0; i < 8; ++i) t[i] = __builtin_amdgcn_exp2f(t[i]);
                        __builtin_amdgcn_sched_barrier(0);
#pragma unroll
                        for (int i = 0; i < 8; ++i) t[i] = __builtin_fmaf(t[i], 1.0f / 255.0f, 1.0f / 255.0f);
                        __builtin_amdgcn_sched_barrier(0);
#pragma unroll
                        for (int i = 0; i < 8; ++i) t[i] = __builtin_amdgcn_rcpf(t[i]);
                        __builtin_amdgcn_sched_barrier(0);
#pragma unroll
                        for (int i = 0; i < 8; ++i) t[i] = __builtin_rintf(t[i]);
                        __builtin_amdgcn_sched_barrier(0);
#pragma unroll
                        for (int n = 0; n < 2; ++n) { unsigned p = 0u;
#pragma unroll
                            for (int j = 0; j < 4; ++j) p = __builtin_amdgcn_cvt_pk_u8_f32(t[4 * n + j], j, p);
                            w[bj * 2 + n] = p; } }
                    st128<PM>(rg, (u32x4){w[0], w[1], w[2], w[3]}, vadd(vb, (ai * 4 + m) * 8192), 0); }
        }
        else if (pn < 3) {
            const int b = u.pm >> 6, t0 = (u.pm & 63) * 256 + wr * 64 + fr;
            blocked<0>(acc, ra, (pn * MR + ((b * 4 + (wc >> 1)) * 2 + (wc & 1)) * 524288 + t0 * 32 + 8 * fq) * 2, 128 * 32, 16 * 32, 4 * 524288);
        } else if (pn == 9) {
            blocked<0>(acc, ra, (9 * MR + row0 * 256 + wc * 32 + 8 * fq) * 2, 128 * 256, 16 * 256, 128);
        } else {
            const int vo = ((pn < 7 ? 5 : 7) * MR + (((u.pm * 8 + ((pn - 5) & 1) * 2) * 4 + wc) * 128 + wr * 64 + fr) * 32 + 8 * fq) * 2;
            if (pn < 7) blocked<0>(acc, ra, vo, 65536, 512, 16384); else blocked<1>(acc, ra, vo, 65536, 512, 16384);
        }
    }
};
typedef EpiInProjT<0> EpiInProj;

struct EpiMerge {
    static constexpr bool PERM = true, AFTER_DRAIN = false, HAS_MID = true; static constexpr int MID0 = 4, MID1 = 12, NST = 16;
    bf16_t* O; const bf16_t* PG;
    __device__ __forceinline__ void mid(f32x4 (&acc)[2][2][4][2], const Unit& u, int t, int wr, int wc, int fr, int fq) const {
        const rsrc_t rg = mkrsrc(PG, MROWS * 3072u);
        const int br = (t == MID0 ? 0 : 1);
        const int va = (u.pm * 12 + br * 4 + u.pn) * 65536 + ((wr * 4 + wc) * 64 + fq * 16 + fr) * 16, vb = va + 4 * 65536;
        u32x4 ga[2][4], gb[2][4];
#pragma unroll
        for (int ai = 0; ai < 2; ++ai)
#pragma unroll
            for (int m = 0; m < 4; ++m) { ga[ai][m] = bl128(rg, vadd(va, (ai * 4 + m) * 8192), 0); gb[ai][m] = bl128(rg, vadd(vb, (ai * 4 + m) * 8192), 0); }
#pragma unroll
        for (int ai = 0; ai < 2; ++ai)
#pragma unroll
            for (int m = 0; m < 4; ++m)
#pragma unroll
                for (int bj = 0; bj < 2; ++bj)
#pragma unroll
                    for (int n = 0; n < 2; ++n) { const unsigned a = ga[ai][m][bj * 2 + n], b = gb[ai][m][bj * 2 + n];
#pragma unroll
                        for (int j = 0; j < 4; ++j) acc[ai][bj][m][n][j] *= (float)((a >> (8 * j)) & 0xffu) * __builtin_amdgcn_rcpf((float)((b >> (8 * j)) & 0xffu)); }
    }
    __device__ __forceinline__ void operator()(const f32x4 (&acc)[2][2][4][2], const Unit& u, int wr, int wc, int fr, int fq, bool newpm) const {
        const bool lo = fr < 8; const int rowb = u.pm * BM + wr * 64, colw = u.pn * BM + wc * 64 + 8 * fq;
        const rsrc_t rg = mkrsrc(PG, MROWS * 3072u), ro = mkrsrc(O, MROWS * 1024u * 2u);
        const int vA = ((rowb + (lo ? fr : fr - 8)) * 1024 + colw + (lo ? 0 : 32)) * 2, vB = ((rowb + (lo ? fr + 8 : fr)) * 1024 + colw + (lo ? 32 : 0)) * 2;
        const int vg = (u.pm * 12 + 2 * 4 + u.pn) * 65536 + ((wr * 4 + wc) * 64 + fq * 16 + fr) * 16;
        u32x4 ga[2][4];
#pragma unroll
        for (int ai = 0; ai < 2; ++ai)
#pragma unroll
            for (int m = 0; m < 4; ++m) ga[ai][m] = bl128(rg, vadd(vg, (ai * 4 + m) * 8192), 0);
#pragma unroll
        for (int ai = 0; ai < 2; ++ai)
#pragma unroll
            for (int m = 0; m < 4; ++m)
                { u32x4 pk[2];
#pragma unroll
                  for (int bj = 0; bj < 2; ++bj) { unsigned w[4];
#pragma unroll
                    for (int q = 0; q < 4; ++q) { const int n = q >> 1, j = (q & 1) * 2; const unsigned a = ga[ai][m][bj * 2 + n];
                        w[q] = pk_bf16(acc[ai][bj][m][n][j] * ((float)((a >> (8 * j)) & 0xffu) * (1.0f / 255.0f)), acc[ai][bj][m][n][j + 1] * ((float)((a >> (8 * j + 8)) & 0xffu) * (1.0f / 255.0f))); }
                    pk[bj] = (u32x4){w[0], w[1], w[2], w[3]}; }
                  u32x4 a, b; line_pack(lo, pk[0], pk[1], a, b); const int ro_ = (ai * HALF + m * 16) * 1024 * 2; bs128(ro, a, vadd(vA, ro_), 0); bs128(ro, b, vadd(vB, ro_), 0); }
    }
};

struct EpiNull {
    static constexpr bool PERM = false, AFTER_DRAIN = false, HAS_MID = false; static constexpr int MID0 = -1, MID1 = -1, NST = 0;
    __device__ __forceinline__ void mid(f32x4 (&)[2][2][4][2], const Unit&, int, int, int, int, int) const {}
    __device__ __forceinline__ void operator()(const f32x4 (&acc)[2][2][4][2], const Unit&, int, int, int, int, bool) const {
#pragma unroll
        for (int ai = 0; ai < 2; ++ai)
#pragma unroll
            for (int bj = 0; bj < 2; ++bj)
#pragma unroll
                for (int m = 0; m < 4; ++m)
#pragma unroll
                    for (int n = 0; n < 2; ++n) asm volatile("" :: "v"(acc[ai][bj][m][n]));
    }
};

template <class Epi, class Sched, bool ALIGN_EPI = false, bool SP2 = false, bool ABLK = false>
__device__ __forceinline__ void gemm_phase(PG8_LAS unsigned char* lds, const Gemm g, const Sched& S, const Epi& E) {
    int tid_op = threadIdx.x; asm volatile("" : "+v"(tid_op));
    const int tid = tid_op, wid = __builtin_amdgcn_readfirstlane(tid >> 6), lane = tid & 63, wr = wid >> 2, wc = wid & 3, fr = lane & 15, fq = lane >> 4;
    const int K = g.K, nt = K / BK;
    unsigned voffA[2], voffB[2];
#pragma unroll
    for (int i = 0; i < 2; ++i) { int R, C; stage_rc(tid * 16 + i * 8192, R, C); const int Rb = Epi::PERM ? ((R & ~31) + perm32(R & 31)) : R;
        voffA[i] = ABLK ? (unsigned)((R * 32 + (C & 31)) * 2 + (C >> 5) * 16384) : (unsigned)(R * K + C) * 2u; voffB[i] = (unsigned)((Rb * 32 + (C & 31)) * 2 + (C >> 5) * 16384); }
    const size_t kstep = ABLK ? (size_t)32768 : (size_t)(BK * 2);
    const size_t hstep = ABLK ? (size_t)8192 : (size_t)HALF * K * 2;
    const size_t tstep = ABLK ? (size_t)nt * 32768 : 2 * hstep;
    const size_t kstepB = 32768, hstepB = 8192, tstepB = (size_t)nt * 32768;
    const unsigned ldsw = (unsigned)wid * 1024u;
    const int aoff = lds_byte(wr * 64 + fr, fq * 8), boff = lds_byte(wc * 32 + fr, fq * 8);
#define PG8_SA(b, h) (((b) * 2 + (h)) * HTB)
#define PG8_SB(b, h) ((4 + (b) * 2 + (h)) * HTB)
#define PG8_STAGE(bufoff, gbase, voff) do { _Pragma("unroll") for (int _i = 0; _i < 2; ++_i) \
        __builtin_amdgcn_global_load_lds((const unsigned*)((const char*)(gbase) + (voff)[_i]), (PG8_LAS unsigned*)(lds + (bufoff) + ldsw + _i * 8192), 16, 0, 0); } while (0)
#define PG8_LDA(dst, b, h) do { _Pragma("unroll") for (int m = 0; m < 4; ++m) _Pragma("unroll") for (int k = 0; k < 2; ++k) dst[m][k] = *(const PG8_LAS bf16x8*)(lds + PG8_SA(b, h) + aoff + m * 2048 + k * 1024); } while (0)
#define PG8_LDB(dst, b, h) do { _Pragma("unroll") for (int n = 0; n < 2; ++n) _Pragma("unroll") for (int k = 0; k < 2; ++k) dst[n][k] = *(const PG8_LAS bf16x8*)(lds + PG8_SB(b, h) + boff + n * 2048 + k * 1024); } while (0)
#define PG8_MMA(ai, bj, At, Bt) do { __builtin_amdgcn_s_setprio(1); _Pragma("unroll") for (int m = 0; m < 4; ++m) _Pragma("unroll") for (int n = 0; n < 2; ++n) _Pragma("unroll") for (int k = 0; k < 2; ++k) \
        acc[ai][bj][m][n] = __builtin_amdgcn_mfma_f32_16x16x32_bf16(Bt[n][k], At[m][k], acc[ai][bj][m][n], 0, 0, 0); __builtin_amdgcn_s_setprio(0); } while (0)
#define PG8_WAIT_V(n) asm volatile("s_waitcnt vmcnt(" #n ")" ::: "memory")
#define PG8_WAIT_L(n) asm volatile("s_waitcnt lgkmcnt(" #n ")" ::: "memory")
#define PG8_WAIT_V8R(relax) do { if (relax) asm volatile("s_waitcnt vmcnt(%0)" :: "n"(8 + Epi::NST) : "memory"); else PG8_WAIT_V(8); } while (0)
#define PG8_BAR __builtin_amdgcn_s_barrier()
#define PG8_SCHED __builtin_amdgcn_sched_barrier(0)
    Unit cur, nxt; int ui = 0; int prev_pm = -1;
    if (!S.next(0, cur)) return;
    f32x4 acc[2][2][4][2];
#pragma unroll
    for (int a = 0; a < 2; ++a)
#pragma unroll
        for (int b = 0; b < 2; ++b)
#pragma unroll
            for (int m = 0; m < 4; ++m)
#pragma unroll
                for (int n = 0; n < 2; ++n) acc[a][b][m][n] = (f32x4){0.f, 0.f, 0.f, 0.f};
    bf16x8 At[4][2], B0[2][2], B1[2][2];
    const char* cA = (const char*)g.A + (size_t)cur.pm * tstep; const char* cB = (const char*)g.Bt + (size_t)cur.pn * tstepB;
    S.a_ready(cur);
    if constexpr (SP2) {
        PG8_STAGE(PG8_SB(0, 0), cB, voffB); PG8_STAGE(PG8_SB(0, 1), cB + hstepB, voffB); PG8_STAGE(PG8_SA(0, 0), cA, voffA); PG8_STAGE(PG8_SA(0, 1), cA + hstep, voffA);
        if (wr == 1) PG8_BAR;
        PG8_WAIT_V(2); PG8_BAR;
        PG8_STAGE(PG8_SB(1, 0), cB + kstepB, voffB); PG8_STAGE(PG8_SA(1, 0), cA + kstep, voffA); PG8_STAGE(PG8_SB(1, 1), cB + hstepB + kstepB, voffB);
        PG8_WAIT_V(6); PG8_BAR;
    } else {
        PG8_STAGE(PG8_SB(0, 0), cB, voffB); PG8_STAGE(PG8_SA(0, 0), cA, voffA); PG8_STAGE(PG8_SB(0, 1), cB + hstepB, voffB); PG8_STAGE(PG8_SA(0, 1), cA + hstep, voffA);
        if (wr == 1) PG8_BAR;
        PG8_WAIT_V(4); PG8_BAR;
        PG8_STAGE(PG8_SB(1, 0), cB + kstepB, voffB); PG8_STAGE(PG8_SA(1, 0), cA + kstep, voffA); PG8_STAGE(PG8_SB(1, 1), cB + hstepB + kstepB, voffB);
        PG8_WAIT_V(6); PG8_BAR;
    }
    for (;;) {
        const bool has_next = S.next(ui + 1, nxt);
        const char* nA = has_next ? (const char*)g.A + (size_t)nxt.pm * tstep : cA; const char* nB = has_next ? (const char*)g.Bt + (size_t)nxt.pn * tstepB : cB;
        for (int t = 0; t < nt; t += 2) {
            const bool last = (t == nt - 2); int relax_ = __builtin_amdgcn_readfirstlane((int)((t == 0) & (ui > 0) & (Epi::NST > 0))); asm volatile("" : "+s"(relax_)); const bool relax = relax_ != 0;
            const char* a1 = cA + (size_t)(t + 1) * kstep;
            const char* a2 = last ? nA : cA + (size_t)(t + 2) * kstep; const char* b2 = last ? nB : cB + (size_t)(t + 2) * kstepB;
            const char* a3 = a2 + kstep; const char* b3 = b2 + kstepB;
            if (last && has_next) S.a_ready(nxt);
            if constexpr (Epi::HAS_MID) { if (t == Epi::MID0 || t == Epi::MID1) E.mid(acc, cur, t, wr, wc, fr, fq); }
            if constexpr (SP2) {
            PG8_LDB(B0, 0, 0); PG8_LDB(B1, 0, 1); PG8_SCHED; PG8_LDA(At, 0, 0); PG8_STAGE(PG8_SA(1, 1), a1 + hstep, voffA);
            PG8_WAIT_V8R(relax); PG8_WAIT_L(0); PG8_BAR; PG8_MMA(0, 0, At, B0); PG8_MMA(0, 1, At, B1); PG8_BAR; PG8_SCHED;
            PG8_LDA(At, 0, 1); PG8_STAGE(PG8_SB(0, 0), b2, voffB); PG8_STAGE(PG8_SB(0, 1), b2 + hstepB, voffB); PG8_STAGE(PG8_SA(0, 0), a2, voffA);
            PG8_WAIT_V8R(relax); PG8_WAIT_L(0); PG8_BAR; PG8_MMA(1, 0, At, B0); PG8_MMA(1, 1, At, B1); PG8_BAR; PG8_SCHED;
            PG8_LDB(B0, 1, 0); PG8_LDB(B1, 1, 1); PG8_SCHED; PG8_LDA(At, 1, 0); PG8_STAGE(PG8_SA(0, 1), a2 + hstep, voffA);
            PG8_WAIT_V(8); PG8_WAIT_L(0); PG8_BAR; PG8_MMA(0, 0, At, B0); PG8_MMA(0, 1, At, B1); PG8_BAR; PG8_SCHED;
            PG8_LDA(At, 1, 1); PG8_STAGE(PG8_SB(1, 0), b3, voffB); PG8_STAGE(PG8_SB(1, 1), b3 + hstepB, voffB); PG8_STAGE(PG8_SA(1, 0), a3, voffA);
            PG8_WAIT_V(8); PG8_WAIT_L(0); PG8_BAR; PG8_MMA(1, 0, At, B0); PG8_MMA(1, 1, At, B1); PG8_BAR; PG8_SCHED;
            } else {
            PG8_LDB(B0, 0, 0); PG8_SCHED; PG8_LDA(At, 0, 0); PG8_STAGE(PG8_SA(1, 1), a1 + hstep, voffA);
            PG8_WAIT_L(8); PG8_BAR; PG8_WAIT_L(0); PG8_MMA(0, 0, At, B0); PG8_BAR; PG8_SCHED;
            PG8_LDB(B1, 0, 1); PG8_STAGE(PG8_SB(0, 0), b2, voffB);
            PG8_BAR; PG8_WAIT_L(0); PG8_MMA(0, 1, At, B1); PG8_BAR;
            PG8_LDA(At, 0, 1); PG8_STAGE(PG8_SA(0, 0), a2, voffA);
            PG8_BAR; PG8_WAIT_L(0); PG8_MMA(1, 0, At, B0); PG8_BAR; PG8_SCHED;
            PG8_STAGE(PG8_SB(0, 1), b2 + hstepB, voffB);
            PG8_WAIT_V(6); PG8_BAR; PG8_MMA(1, 1, At, B1); PG8_BAR;
            PG8_LDB(B0, 1, 0); PG8_SCHED; PG8_LDA(At, 1, 0); PG8_STAGE(PG8_SA(0, 1), a2 + hstep, voffA);
            PG8_WAIT_L(8); PG8_BAR; PG8_WAIT_L(0); PG8_MMA(0, 0, At, B0); PG8_BAR; PG8_SCHED;
            PG8_LDB(B1, 1, 1); PG8_STAGE(PG8_SB(1, 0), b3, voffB);
            PG8_BAR; PG8_WAIT_L(0); PG8_MMA(0, 1, At, B1); PG8_BAR;
            PG8_LDA(At, 1, 1); PG8_STAGE(PG8_SA(1, 0), a3, voffA);
            PG8_BAR; PG8_WAIT_L(0); PG8_MMA(1, 0, At, B0); PG8_BAR; PG8_SCHED;
            PG8_STAGE(PG8_SB(1, 1), b3 + hstepB, voffB);
            PG8_WAIT_V(6); PG8_BAR; PG8_MMA(1, 1, At, B1); PG8_BAR;
            }
        }
        if constexpr (ALIGN_EPI) { if (wr == 0) PG8_BAR; }
        if constexpr (!Epi::AFTER_DRAIN) { E(acc, cur, wr, wc, fr, fq, cur.pm != prev_pm); prev_pm = cur.pm; S.done(cur); }
        if (!has_next) break;
#pragma unroll
        for (int a = 0; a < 2; ++a)
#pragma unroll
            for (int b = 0; b < 2; ++b)
#pragma unroll
                for (int m = 0; m < 4; ++m)
#pragma unroll
                    for (int n = 0; n < 2; ++n) acc[a][b][m][n] = (f32x4){0.f, 0.f, 0.f, 0.f};
        cur = nxt; cA = nA; cB = nB; ++ui;
        if constexpr (ALIGN_EPI) { if (wr == 1) PG8_BAR; }
    }
    PG8_WAIT_V(0);
    if constexpr (!ALIGN_EPI) { if (wr == 0) PG8_BAR; }
    PG8_BAR;
    if constexpr (Epi::AFTER_DRAIN) { E.fused(acc, cur, wr, wc, fr, fq, lds, wid, lane); S.done(cur); }
#undef PG8_SA
#undef PG8_SB
#undef PG8_STAGE
#undef PG8_LDA
#undef PG8_LDB
#undef PG8_MMA
#undef PG8_WAIT_V
#undef PG8_WAIT_L
#undef PG8_WAIT_V8R
#undef PG8_BAR
#undef PG8_SCHED
}
}


constexpr int NWAVES = 8;
constexpr int BATCH = 2, SEQ = 16384, DM = 1024, DFF = 2816, DIN = 5632, DEPTH = 2;
constexpr int M = BATCH * SEQ;
constexpr int PA_LD = 2560, PG_LD = 3072;
constexpr size_t MR = (size_t)32768 * 256;
constexpr size_t PA_QSB = 0, PA_KSB = MR, PA_VSB = 2 * MR, PA_QR = 3 * MR, PA_KR = 4 * MR, PA_VR = 5 * MR, PA_GR = 7 * MR, PA_UP = 9 * MR;
constexpr int Y_SB = 0, Y_RET = 256, Y_POOL = 768;
constexpr int NCHUNK = SEQ / 128;
constexpr size_t MiB = 1u << 20;
constexpr size_t WS_CTL = 0, CTL_ZERO_BYTES = 64 * 1024;
constexpr size_t WS_SSQ = 1 * MiB;
constexpr size_t WS_ROPE = 2 * MiB;
constexpr size_t WS_W = 6 * MiB;
constexpr size_t W_13A = 0, W_2A = 11534336, W_IN = 17301504, W_B = 28835840, W_OUT = 30932992, W_13B = 33030144, W_2B = 44564480;
constexpr size_t WS_STATE = WS_W;
constexpr size_t WS_XB = 54 * MiB;
constexpr size_t WS_PA = 118 * MiB;
constexpr size_t WS_MRG = WS_PA;
constexpr size_t WS_ACT = WS_PA;
constexpr size_t WS_PG = 278 * MiB;
constexpr size_t WS_KV = 470 * MiB;
constexpr size_t WS_END = 502 * MiB;
static_assert(W_2B + 5767168 <= 48 * MiB && WS_W + 48 * MiB <= WS_XB && WS_XB + (size_t)M * 1024 * 2 <= WS_PA && WS_PA + (size_t)M * 2560 * 2 <= WS_PG && WS_PG + (size_t)M * 3072 * 2 <= WS_KV && WS_ACT + (size_t)M * 2816 * 2 <= WS_KV && WS_KV + 32 * MiB <= WS_END, "ws map");
constexpr int RING_BYTES = 131072;
constexpr int PSTAT_OFF = RING_BYTES;
constexpr int MISC_OFF = PSTAT_OFF + 4096;
constexpr int LDS_BYTES = 147456;

#define GAS __attribute__((address_space(1)))
#define LAS __attribute__((address_space(3)))
typedef unsigned short bf16;
typedef float f32x4 __attribute__((ext_vector_type(4)));
typedef float f32x16 __attribute__((ext_vector_type(16)));
typedef short bf16x8 __attribute__((ext_vector_type(8)));
typedef short s16x4 __attribute__((ext_vector_type(4)));
typedef unsigned u32x4 __attribute__((ext_vector_type(4)));
typedef unsigned u32x2 __attribute__((ext_vector_type(2)));
using pg8::pk_bf16; using pg8::bf_lo; using pg8::bf_hi; using pg8::l2gamma;

#define XB_TMO      128
#define XB_XCNT(j)  (256  + 64 * (j))
#define XB_XSUB(j)  (1280 + 64 * (j))
#define XB_XGEN(j)  (2304 + 64 * (j))
#define XB_TOP      3328
#define XB_TOPGEN   3392
#define XCD_BAR_WORDS 3456
#define XB_SPIN_CAP (1u << 18)

__device__ __forceinline__ unsigned xb_ld(unsigned* p)              { return __hip_atomic_load(p, __ATOMIC_RELAXED, __HIP_MEMORY_SCOPE_AGENT); }
__device__ __forceinline__ unsigned xb_add(unsigned* p, unsigned v) { return __hip_atomic_fetch_add(p, v, __ATOMIC_RELAXED, __HIP_MEMORY_SCOPE_AGENT); }
__device__ __forceinline__ unsigned xb_xcc_id() { return (unsigned)__builtin_amdgcn_s_getreg((3 << 11) | 20) & 0xFu; }
#define XB_SPIN(cond, bar) do { unsigned _sp = 0; while (cond) { __builtin_amdgcn_s_sleep(1); \
    if ((++_sp & 255u) == 0u) { if (xb_ld(&(bar)[XB_TMO])) break; if (_sp > XB_SPIN_CAP) { atomicAdd(&(bar)[XB_TMO], 1u); break; } } } } while (0)

struct XcdBarrier {
    unsigned* bar; unsigned x;
    volatile LAS unsigned* st;
};

__device__ __forceinline__ XcdBarrier xcd_barrier_post(unsigned* bar, volatile LAS unsigned* st) {
    XcdBarrier b; b.bar = bar; b.x = xb_xcc_id(); b.st = st;
    if (threadIdx.x == 0) (void)xb_add(&bar[XB_XCNT(b.x)], 1u);
    return b;
}
__device__ __forceinline__ void xcd_barrier_complete(unsigned* bar, unsigned x, unsigned& nloc, unsigned& nx) {
    const unsigned G = gridDim.x * gridDim.y * gridDim.z;
    unsigned sum, cnt, mine, sp = 0u;
    for (;;) {
        sum = 0u; cnt = 0u; mine = 0u;
#pragma unroll
        for (unsigned j = 0; j < 16; ++j) { const unsigned c = xb_ld(&bar[XB_XCNT(j)]); sum += c; cnt += (c > 0u) ? 1u : 0u; mine = (j == x) ? c : mine; }
        if (sum == G) break;
        __builtin_amdgcn_s_sleep(1);
        if ((++sp & 255u) == 0u) { if (xb_ld(&bar[XB_TMO])) break; if (sp > XB_SPIN_CAP) { atomicAdd(&bar[XB_TMO], 1u); break; } }
    }
    nloc = mine > 0u ? mine : 1u; nx = cnt > 0u ? cnt : 1u;
}

__device__ __forceinline__ void xcd_barrier(const XcdBarrier& b) {
    asm volatile("s_waitcnt vmcnt(0)" ::: "memory");
    __syncthreads();
    if (threadIdx.x == 0) {
        unsigned* bar = b.bar;
        __builtin_amdgcn_s_waitcnt(0);
        unsigned nloc = b.st[0], nx = b.st[1];
        if (nloc == 0u) { xcd_barrier_complete(bar, b.x, nloc, nx); b.st[0] = nloc; b.st[1] = nx; }
        const unsigned old = xb_add(&bar[XB_XSUB(b.x)], 1u);
        const unsigned gen = old / nloc;
        if (old + 1u == (gen + 1u) * nloc) {
            __builtin_amdgcn_fence(__ATOMIC_RELEASE, "agent");
            asm volatile("s_waitcnt vmcnt(0)" ::: "memory");
            const unsigned og = xb_add(&bar[XB_TOP], 1u);
            const unsigned tg = og / nx;
            if (og + 1u == (tg + 1u) * nx) xb_add(&bar[XB_TOPGEN], 1u);
            else XB_SPIN(xb_ld(&bar[XB_TOPGEN]) == tg, bar);
            __builtin_amdgcn_fence(__ATOMIC_ACQUIRE, "agent");
            xb_add(&bar[XB_XGEN(b.x)], 1u);
            asm volatile("s_waitcnt vmcnt(0)" ::: "memory");
        } else {
            XB_SPIN(xb_ld(&bar[XB_XGEN(b.x)]) == gen, bar);
            __builtin_amdgcn_fence(__ATOMIC_ACQUIRE, "agent");
            asm volatile("s_waitcnt vmcnt(0)" ::: "memory");
        }
    }
    __syncthreads();
}


__device__ __forceinline__ float wave_sum(float v) {
#pragma unroll
    for (int o = 1; o < 64; o <<= 1) v += __shfl_xor(v, o);
    return v;
}
__device__ __forceinline__ float xhalf(float v) { return __shfl_xor(v, 32); }
__device__ __forceinline__ s16x4 vtr(LAS const unsigned char* p) { return __builtin_bit_cast(s16x4, __builtin_amdgcn_ds_read_tr16_b64_v4i16((LAS s16x4*)p)); }
__device__ __forceinline__ bf16x8 trfrag(LAS const unsigned char* img, int ks, int laneoff) {
    const s16x4 lo = vtr(img + ks * 1024 + laneoff), hi = vtr(img + ks * 1024 + 512 + laneoff);
    return (bf16x8){lo[0], lo[1], lo[2], lo[3], hi[0], hi[1], hi[2], hi[3]};
}
__device__ __forceinline__ bf16x8 accfrag(const f32x16& p, int s) {
    const u32x4 w = {pk_bf16(p[8 * s + 0], p[8 * s + 1]), pk_bf16(p[8 * s + 2], p[8 * s + 3]), pk_bf16(p[8 * s + 4], p[8 * s + 5]), pk_bf16(p[8 * s + 6], p[8 * s + 7])};
    return __builtin_bit_cast(bf16x8, w);
}
__device__ __forceinline__ void stage128x32(LAS unsigned char* img, const bf16* src, int ld, int lane) {
    u32x4 v[8];
#pragma unroll
    for (int i = 0; i < 8; ++i) { const int c = lane + 64 * i, key = c >> 2, ch = c & 3; v[i] = *(const u32x4*)(src + (size_t)key * ld + ch * 8); }
#pragma unroll
    for (int i = 0; i < 8; ++i) { const int c = lane + 64 * i, key = c >> 2, ch = c & 3; *(LAS u32x4*)(img + (key >> 4) * 1024 + (key & 15) * 64 + ch * 16) = v[i]; }
}

__device__ __forceinline__ void sb_exp(const f32x16& z, float (&e)[16]) {
#pragma unroll
    for (int r = 0; r < 16; ++r) e[r] = __builtin_amdgcn_exp2f(__builtin_amdgcn_fmed3f(z[r], -200.f, 30.f));
}
__device__ __forceinline__ void sb_mask(float (&e)[16], int lim2) {
#pragma unroll
    for (int g = 0; g < 4; ++g)
#pragma unroll
        for (int i = 0; i < 4; ++i) e[4 * g + i] = (i + 8 * g < lim2) ? e[4 * g + i] : 0.f;
}
__device__ __forceinline__ void sb_weights(const float (&e)[16], f32x16& w, float& run, bool lo_half) {
    float P[4][3], cs[4], clo[4], chi[4];
#pragma unroll
    for (int g = 0; g < 4; ++g) {
        P[g][0] = 1.0f + e[4 * g]; P[g][1] = P[g][0] * (1.0f + e[4 * g + 1]); P[g][2] = P[g][1] * (1.0f + e[4 * g + 2]);
        cs[g] = __builtin_amdgcn_rcpf(P[g][2] * (1.0f + e[4 * g + 3]));
        clo[g] = cs[g]; chi[g] = cs[g];
        asm("s_nop 1\n\tv_permlane32_swap_b32 %0, %1" : "+v"(clo[g]), "+v"(chi[g])); }
    float T[4]; T[3] = run; T[2] = T[3] * (clo[3] * chi[3]); T[1] = T[2] * (clo[2] * chi[2]); T[0] = T[1] * (clo[1] * chi[1]); run = T[0] * (clo[0] * chi[0]);
#pragma unroll
    for (int g = 0; g < 4; ++g) { const float R = cs[g] * (T[g] * (lo_half ? chi[g] : 1.0f));
        w[4 * g] = e[4 * g] * R; w[4 * g + 1] = e[4 * g + 1] * (P[g][0] * R); w[4 * g + 2] = e[4 * g + 2] * (P[g][1] * R); w[4 * g + 3] = e[4 * g + 3] * (P[g][2] * R); }
}
__device__ __forceinline__ void sb_item(const bf16* PA_, bf16* Y_, LAS unsigned char* wl, int b, int h, int qb, int lane, int force = 0) {
    const GAS bf16* PA = (const GAS bf16*)PA_; GAS bf16* Y = (GAS bf16*)Y_;
    const int r = lane & 31, hi = lane >> 5; const size_t seq0 = (size_t)b * SEQ; const int R0 = qb * 32;
    const int laneoff = (4 * hi + ((lane & 15) >> 2)) * 64 + ((lane >> 4) & 1) * 32 + (lane & 3) * 8;
    bf16x8 qf[4];
    const size_t hb = (size_t)((b * 4 + h) * 2) * (SEQ * 32);
    { const GAS bf16* qp = PA + PA_QSB + hb + (size_t)(R0 + r) * 32 + hi * 8;
#pragma unroll
      for (int kk = 0; kk < 4; ++kk) qf[kk] = *(const GAS bf16x8*)(qp + (size_t)(kk >> 1) * (SEQ * 32) + (kk & 1) * 16); }
    f32x16 o0 = {}, o1 = {}; float carry = 1.0f;
    bf16x8 ka[4], kb[4]; u32x4 vst[8];
    const int J0 = R0 >> 6;
    const GAS bf16* kp = PA + PA_KSB + hb + (size_t)(64 * J0 + r) * 32 + hi * 8;
    const GAS bf16* vp = PA + PA_VSB + hb + (size_t)(64 * J0) * 32 + lane * 8;
#pragma unroll
    for (int kk = 0; kk < 4; ++kk) { ka[kk] = *(const GAS bf16x8*)(kp + (size_t)(kk >> 1) * (SEQ * 32) + (kk & 1) * 16); kb[kk] = *(const GAS bf16x8*)(kp + (size_t)(kk >> 1) * (SEQ * 32) + 32 * 32 + (kk & 1) * 16); }
#pragma unroll
    for (int i = 0; i < 8; ++i) vst[i] = *(const GAS u32x4*)(vp + (size_t)(i >> 2) * (SEQ * 32) + (i & 3) * 512);
    for (int J = J0; J >= 0; --J) {
        f32x16 p0 = {}, p1 = {};
#pragma unroll
        for (int kk = 0; kk < 4; ++kk) { p0 = __builtin_amdgcn_mfma_f32_32x32x16_bf16(ka[kk], qf[kk], p0, 0, 0, 0); p1 = __builtin_amdgcn_mfma_f32_32x32x16_bf16(kb[kk], qf[kk], p1, 0, 0, 0); }
#pragma unroll
        for (int i = 0; i < 8; ++i) *(LAS u32x4*)(wl + i * 1024 + lane * 16) = vst[i];
        if (J > 0) {
            kp -= 64 * 32; vp -= 64 * 32;
#pragma unroll
            for (int kk = 0; kk < 4; ++kk) { ka[kk] = *(const GAS bf16x8*)(kp + (size_t)(kk >> 1) * (SEQ * 32) + (kk & 1) * 16); kb[kk] = *(const GAS bf16x8*)(kp + (size_t)(kk >> 1) * (SEQ * 32) + 32 * 32 + (kk & 1) * 16); }
#pragma unroll
            for (int i = 0; i < 8; ++i) vst[i] = *(const GAS u32x4*)(vp + (size_t)(i >> 2) * (SEQ * 32) + (i & 3) * 512);
        }
        const int lim = R0 + r - 64 * J - 4 * hi;
        bf16x8 vf[8];
#pragma unroll
        for (int i = 0; i < 4; ++i) { vf[i] = trfrag(wl, i, laneoff); vf[4 + i] = trfrag(wl + 4096, i, laneoff); }
        __builtin_amdgcn_sched_barrier(0);
        f32x16 w0, w1; float run = carry; float e0[16], e1[16];
        sb_exp(p1, e1); sb_exp(p0, e0);
        if (J == J0) { sb_mask(e1, lim - 32); sb_mask(e0, lim); }
        sb_weights(e1, w1, run, hi == 0); sb_weights(e0, w0, run, hi == 0);
        carry = run;
        const bf16x8 pf0 = accfrag(w0, 0), pf1 = accfrag(w0, 1), pf2 = accfrag(w1, 0), pf3 = accfrag(w1, 1);
        __builtin_amdgcn_sched_barrier(0);
        o0 = __builtin_amdgcn_mfma_f32_32x32x16_bf16(vf[0], pf0, o0, 0, 0, 0); o1 = __builtin_amdgcn_mfma_f32_32x32x16_bf16(vf[4], pf0, o1, 0, 0, 0);
        o0 = __builtin_amdgcn_mfma_f32_32x32x16_bf16(vf[1], pf1, o0, 0, 0, 0); o1 = __builtin_amdgcn_mfma_f32_32x32x16_bf16(vf[5], pf1, o1, 0, 0, 0);
        o0 = __builtin_amdgcn_mfma_f32_32x32x16_bf16(vf[2], pf2, o0, 0, 0, 0); o1 = __builtin_amdgcn_mfma_f32_32x32x16_bf16(vf[6], pf2, o1, 0, 0, 0);
        o0 = __builtin_amdgcn_mfma_f32_32x32x16_bf16(vf[3], pf3, o0, 0, 0, 0); o1 = __builtin_amdgcn_mfma_f32_32x32x16_bf16(vf[7], pf3, o1, 0, 0, 0);
        asm volatile("" ::: "memory");
        if (force ? (J0 - J + 1 >= force) : (int)__all(carry < 1e-36f)) break;
    }
    { LAS unsigned char* st = wl + 8192 + r * 144 + hi * 8;
#pragma unroll
      for (int g = 0; g < 4; ++g) {
          *(LAS u32x2*)(st + 16 * g) = (u32x2){pk_bf16(o0[4 * g], o0[4 * g + 1]), pk_bf16(o0[4 * g + 2], o0[4 * g + 3])};
          *(LAS u32x2*)(st + 64 + 16 * g) = (u32x2){pk_bf16(o1[4 * g], o1[4 * g + 1]), pk_bf16(o1[4 * g + 2], o1[4 * g + 3])}; }
      asm volatile("" ::: "memory");
      GAS bf16* yb = Y + (seq0 + R0) * 1024 + Y_SB + h * 64 + (lane & 7) * 8;
#pragma unroll
      for (int i = 0; i < 4; ++i) { const int row = 8 * i + (lane >> 3);
          const u32x4 v = *(const LAS u32x4*)(wl + 8192 + row * 144 + (lane & 7) * 16);
          *(GAS u32x4*)(yb + (size_t)row * 1024) = v; }
      asm volatile("" ::: "memory"); }
}

__device__ __forceinline__ void kv_load(const GAS bf16* PA, int it, int lane, u32x4 (&va)[8], u32x4 (&ka)[8]) {
    const int b = it >> 12, n = (it >> 5) & 127, h = (it >> 3) & 3, eb = (it >> 1) & 3, db = it & 1;
    const size_t ch = (size_t)((b * NCHUNK + n) * 4 + h);
    const GAS bf16* vs = PA + PA_VR + (ch * 4 + eb) * 4096 + lane * 8; const GAS bf16* ks = PA + PA_KR + (ch * 2 + db) * 4096 + lane * 8;
#pragma unroll
    for (int i = 0; i < 8; ++i) { va[i] = *(const GAS u32x4*)(vs + i * 512); ka[i] = *(const GAS u32x4*)(ks + i * 512); }
}
__device__ __forceinline__ void kv_items(const bf16* PA_, float* KV_, LAS unsigned char* wl, int gw, int NGW, int lane) {
    const GAS bf16* PA = (const GAS bf16*)PA_; GAS float* KV = (GAS float*)KV_;
    constexpr int NIT = BATCH * NCHUNK * 4 * 8;
    const int r = lane & 31, hi = lane >> 5;
    const int laneoff = (4 * hi + ((lane & 15) >> 2)) * 64 + ((lane >> 4) & 1) * 32 + (lane & 3) * 8;
    const int vdst = (lane >> 2) * 64 + (lane & 3) * 16;
    int it = gw; if (it >= NIT) return;
    u32x4 va[8], ka[8]; kv_load(PA, it, lane, va, ka);
    for (;;) {
#pragma unroll
        for (int i = 0; i < 8; ++i) { *(LAS u32x4*)(wl + i * 1024 + lane * 16) = va[i]; *(LAS u32x4*)(wl + 8192 + i * 1024 + lane * 16) = ka[i]; }
        const int nit = it + NGW; const bool more = nit < NIT;
        if (more) kv_load(PA, nit, lane, va, ka);
        asm volatile("" ::: "memory");
        f32x16 acc = {};
#pragma unroll
        for (int ks = 0; ks < 8; ++ks) acc = __builtin_amdgcn_mfma_f32_32x32x16_bf16(trfrag(wl, ks, laneoff), trfrag(wl + 8192, ks, laneoff), acc, 0, 0, 0);
        asm volatile("" ::: "memory");
        const int b = it >> 12, n = (it >> 5) & 127, h = (it >> 3) & 3, eb = (it >> 1) & 3, db = it & 1;
        const float sc = __builtin_amdgcn_exp2f(127.0f * l2gamma(h));
        GAS float* op = KV + (((size_t)(b * NCHUNK + n) * 4 + h) * 128 + eb * 32 + 4 * hi) * 64 + db * 32 + r;
#pragma unroll
        for (int g = 0; g < 4; ++g)
#pragma unroll
            for (int i = 0; i < 4; ++i) op[(size_t)(8 * g + i) * 64] = acc[4 * g + i] * sc;
        if (!more) break;
        it = nit;
    }
}
__device__ __forceinline__ void kv_group(const bf16* PA_, float* KV_, LAS unsigned char* lds, int vcu, int G, int wave, int lane) {
    constexpr int NCH = BATCH * NCHUNK * 4;
    GAS bf16* KV = (GAS bf16*)KV_;
    const int r = lane & 31, hi = lane >> 5, eb = wave >> 1, db = wave & 1;
    const int laneoff = (4 * hi + ((lane & 15) >> 2)) * 64 + ((lane >> 4) & 1) * 32 + (lane & 3) * 8;
    auto issue = [&](int chh, int buf) {
        const bf16* vb = PA_ + PA_VR + (size_t)chh * 16384 + lane * 8; const bf16* kb = PA_ + PA_KR + (size_t)chh * 8192 + lane * 8;
#pragma unroll
        for (int i = 0; i < 6; ++i) { const int j = wave * 6 + i;
            if (j < 32) __builtin_amdgcn_global_load_lds((const unsigned*)(vb + j * 512), (LAS unsigned*)(lds + buf * 49152 + j * 1024), 16, 0, 0);
            else __builtin_amdgcn_global_load_lds((const unsigned*)(kb + (j - 32) * 512), (LAS unsigned*)(lds + buf * 49152 + j * 1024), 16, 0, 0); } };
    __syncthreads();
    if (vcu < NCH) issue(vcu, 0);
    int k = 0;
    for (int chh = vcu; chh < NCH; chh += G, ++k) {
        if (k == 0) asm volatile("s_waitcnt vmcnt(0)" ::: "memory"); else asm volatile("s_waitcnt vmcnt(16)" ::: "memory");
        __syncthreads(); asm volatile("" ::: "memory");
        if (chh + G < NCH) issue(chh + G, (k + 1) & 1);
        const LAS unsigned char* vi = lds + (k & 1) * 49152 + eb * 8192; const LAS unsigned char* ki = lds + (k & 1) * 49152 + 32768 + db * 8192;
        f32x16 acc = {};
#pragma unroll
        for (int ks = 0; ks < 8; ++ks) acc = __builtin_amdgcn_mfma_f32_32x32x16_bf16(trfrag(vi, ks, laneoff), trfrag(ki, ks, laneoff), acc, 0, 0, 0);
        int hq = __builtin_amdgcn_readfirstlane(chh & 3); asm volatile("" : "+s"(hq));
        const float sc = __builtin_amdgcn_exp2f(127.0f * l2gamma(hq));
        GAS bf16* op = KV + ((size_t)chh * 128 + eb * 32 + 4 * hi) * 64 + db * 32 + r;
#pragma unroll
        for (int g = 0; g < 4; ++g)
#pragma unroll
            for (int i = 0; i < 4; ++i) op[(size_t)(8 * g + i) * 64] = (bf16)(pk_bf16(acc[4 * g + i] * sc, 0.f) & 0xffffu);
    }
    __syncthreads();
}
__device__ __forceinline__ void ret_item(const bf16* PA_, const bf16* STATE_, bf16* Y_, LAS unsigned char* wl, int b, int n, int h, int qb, int lane) {
    const GAS bf16* PA = (const GAS bf16*)PA_; const GAS bf16* STATE = (const GAS bf16*)STATE_; GAS bf16* Y = (GAS bf16*)Y_;
    const int r = lane & 31, hi = lane >> 5; const size_t row0 = (size_t)b * SEQ + (size_t)n * 128;
    const int laneoff = (4 * hi + ((lane & 15) >> 2)) * 64 + ((lane >> 4) & 1) * 32 + (lane & 3) * 8;
    const int vdst = (lane >> 2) * 64 + (lane & 3) * 16;
    bf16x8 qf[4];
    const size_t ch = (size_t)((b * NCHUNK + n) * 4 + h);
    { const GAS bf16* qp = PA + PA_QR + ch * 8192 + (size_t)(qb * 32 + r) * 32 + hi * 8;
#pragma unroll
      for (int kk = 0; kk < 4; ++kk) qf[kk] = *(const GAS bf16x8*)(qp + (kk >> 1) * 4096 + (kk & 1) * 16); }
    const GAS bf16* vsrc = PA + PA_VR + ch * 16384 + lane * 8;
    const GAS bf16* sp = STATE + (((size_t)(b * NCHUNK + n) * 4 + h) * 128 + r) * 64 + hi * 8;
    u32x4 vst[8]; bf16x8 sf[2][4];
#pragma unroll
    for (int i = 0; i < 8; ++i) vst[i] = *(const GAS u32x4*)(vsrc + i * 512);
#pragma unroll
    for (int kk = 0; kk < 4; ++kk) sf[0][kk] = *(const GAS bf16x8*)(sp + 16 * kk);
    bf16x8 pf[4][2];
#pragma unroll
    for (int kb = 0; kb < 4; ++kb) {
        f32x16 p = {};
        if (kb <= qb) {
            const GAS bf16* kp = PA + PA_KR + ch * 8192 + (size_t)(kb * 32 + r) * 32 + hi * 8;
#pragma unroll
            for (int kk = 0; kk < 4; ++kk) p = __builtin_amdgcn_mfma_f32_32x32x16_bf16(*(const GAS bf16x8*)(kp + (kk >> 1) * 4096 + (kk & 1) * 16), qf[kk], p, 0, 0, 0);
            if (kb == qb) {
#pragma unroll
                for (int reg = 0; reg < 16; ++reg) p[reg] = ((reg & 3) + 8 * (reg >> 2) + 4 * hi <= r) ? p[reg] : 0.f;
            }
        }
        pf[kb][0] = accfrag(p, 0); pf[kb][1] = accfrag(p, 1);
    }
    const float gam = __builtin_amdgcn_exp2f(l2gamma(h));
    f32x16 o[4];
#pragma unroll
    for (int eb = 0; eb < 4; ++eb) {
        LAS unsigned char* img = wl + (eb & 1) * 8192;
#pragma unroll
        for (int i = 0; i < 8; ++i) *(LAS u32x4*)(img + i * 1024 + lane * 16) = vst[i];
        if (eb < 3) {
#pragma unroll
            for (int i = 0; i < 8; ++i) vst[i] = *(const GAS u32x4*)(vsrc + (eb + 1) * 4096 + i * 512);
#pragma unroll
            for (int kk = 0; kk < 4; ++kk) sf[(eb + 1) & 1][kk] = *(const GAS bf16x8*)(sp + (size_t)(eb + 1) * 32 * 64 + 16 * kk);
        }
        asm volatile("" ::: "memory");
        f32x16 a = {};
#pragma unroll
        for (int kk = 0; kk < 4; ++kk) a = __builtin_amdgcn_mfma_f32_32x32x16_bf16(sf[eb & 1][kk], qf[kk], a, 0, 0, 0);
        a = a * gam;
#pragma unroll
        for (int kb = 0; kb < 4; ++kb) if (kb <= qb) {
            a = __builtin_amdgcn_mfma_f32_32x32x16_bf16(trfrag(img, 2 * kb, laneoff), pf[kb][0], a, 0, 0, 0);
            a = __builtin_amdgcn_mfma_f32_32x32x16_bf16(trfrag(img, 2 * kb + 1, laneoff), pf[kb][1], a, 0, 0, 0); }
        o[eb] = a;
    }
    asm volatile("" ::: "memory");
    float ss = 0.f;
#pragma unroll
    for (int eb = 0; eb < 4; ++eb)
#pragma unroll
        for (int reg = 0; reg < 16; ++reg) ss += o[eb][reg] * o[eb][reg];
    ss += xhalf(ss);
    const float rn = __builtin_amdgcn_rsqf(ss * (1.0f / 128.0f) + 1e-6f);
    const GAS bf16* gp = PA + PA_GR + ch * 16384 + (size_t)(qb * 32 + r) * 32 + 4 * hi;
    GAS bf16* yp = Y + (row0 + qb * 32 + r) * 1024 + Y_RET + h * 128 + 4 * hi;
#pragma unroll
    for (int eb = 0; eb < 4; ++eb)
#pragma unroll
        for (int g = 0; g < 4; ++g) { const u32x2 gv = *(const GAS u32x2*)(gp + eb * 4096 + 8 * g);
            *(GAS u32x2*)(yp + eb * 32 + 8 * g) = (u32x2){pk_bf16(o[eb][4 * g] * rn * bf_lo(gv[0]), o[eb][4 * g + 1] * rn * bf_hi(gv[0])), pk_bf16(o[eb][4 * g + 2] * rn * bf_lo(gv[1]), o[eb][4 * g + 3] * rn * bf_hi(gv[1]))}; }
}

__device__ __forceinline__ void ret_group(const bf16* PA_, const bf16* STATE_, bf16* Y_, LAS unsigned char* lds, int cp, int wave, int lane) {
    const GAS bf16* PA = (const GAS bf16*)PA_; const GAS bf16* STATE = (const GAS bf16*)STATE_; GAS bf16* Y = (GAS bf16*)Y_;
    const int grp = wave >> 2, qb = wave & 3, r = lane & 31, hi = lane >> 5;
    const int chh = cp * 2 + grp, h = chh & 3, cn = chh >> 2;
    const size_t ch = (size_t)chh; const size_t row0 = (size_t)cn * 128;
    const int laneoff = (4 * hi + ((lane & 15) >> 2)) * 64 + ((lane >> 4) & 1) * 32 + (lane & 3) * 8;
    LAS unsigned char* gl = lds + grp * 49152;
    __syncthreads();
    { const bf16* vb = (const bf16*)PA_ + PA_VR + ch * 16384 + lane * 8;
#pragma unroll
      for (int j = 0; j < 8; ++j) { const int jj = qb * 8 + j; __builtin_amdgcn_global_load_lds((const unsigned*)(vb + jj * 512), (LAS unsigned*)(gl + jj * 1024), 16, 0, 0); }
      const bf16* sb = (const bf16*)STATE_ + ch * 8192;
#pragma unroll
      for (int j = 0; j < 4; ++j) { const int jj = qb * 4 + j, row = jj * 8 + (lane >> 3), p = (lane & 7) ^ (row & 7);
          __builtin_amdgcn_global_load_lds((const unsigned*)(sb + row * 64 + p * 8), (LAS unsigned*)(gl + 32768 + jj * 1024), 16, 0, 0); } }
    bf16x8 qf[4];
    { const GAS bf16* qp = PA + PA_QR + ch * 8192 + (size_t)(qb * 32 + r) * 32 + hi * 8;
#pragma unroll
      for (int kk = 0; kk < 4; ++kk) qf[kk] = *(const GAS bf16x8*)(qp + (kk >> 1) * 4096 + (kk & 1) * 16); }
    bf16x8 kf[4][4];
    { const GAS bf16* kp = PA + PA_KR + ch * 8192 + (size_t)r * 32 + hi * 8;
#pragma unroll
      for (int kb = 0; kb < 4; ++kb) if (kb <= qb) {
#pragma unroll
          for (int kk = 0; kk < 4; ++kk) kf[kb][kk] = *(const GAS bf16x8*)(kp + kb * 1024 + (kk >> 1) * 4096 + (kk & 1) * 16); } }
    bf16x8 pf[4][2];
#pragma unroll
    for (int kb = 0; kb < 4; ++kb) {
        f32x16 p = {};
        if (kb <= qb) {
#pragma unroll
            for (int kk = 0; kk < 4; ++kk) p = __builtin_amdgcn_mfma_f32_32x32x16_bf16(kf[kb][kk], qf[kk], p, 0, 0, 0);
            if (kb == qb) {
#pragma unroll
                for (int reg = 0; reg < 16; ++reg) p[reg] = ((reg & 3) + 8 * (reg >> 2) + 4 * hi <= r) ? p[reg] : 0.f;
            }
        }
        pf[kb][0] = accfrag(p, 0); pf[kb][1] = accfrag(p, 1);
    }
    asm volatile("s_waitcnt vmcnt(0)" ::: "memory"); __syncthreads(); asm volatile("" ::: "memory");
    const float gam = __builtin_amdgcn_exp2f(l2gamma(h));
    f32x16 o[4];
#pragma unroll
    for (int eb = 0; eb < 4; ++eb) {
        const LAS unsigned char* img = gl + eb * 8192; const int row = eb * 32 + r;
        f32x16 a = {};
#pragma unroll
        for (int kk = 0; kk < 4; ++kk) a = __builtin_amdgcn_mfma_f32_32x32x16_bf16(*(const LAS bf16x8*)(gl + 32768 + row * 128 + (((kk * 2 + hi) ^ (row & 7)) * 16)), qf[kk], a, 0, 0, 0);
        a = a * gam;
#pragma unroll
        for (int kb = 0; kb < 4; ++kb) if (kb <= qb) {
            a = __builtin_amdgcn_mfma_f32_32x32x16_bf16(trfrag((LAS const unsigned char*)img, 2 * kb, laneoff), pf[kb][0], a, 0, 0, 0);
            a = __builtin_amdgcn_mfma_f32_32x32x16_bf16(trfrag((LAS const unsigned char*)img, 2 * kb + 1, laneoff), pf[kb][1], a, 0, 0, 0); }
        o[eb] = a;
    }
    asm volatile("" ::: "memory");
    float ss = 0.f;
#pragma unroll
    for (int eb = 0; eb < 4; ++eb)
#pragma unroll
        for (int reg = 0; reg < 16; ++reg) ss += o[eb][reg] * o[eb][reg];
    ss += xhalf(ss);
    const float rn = __builtin_amdgcn_rsqf(ss * (1.0f / 128.0f) + 1e-6f);
    __syncthreads();
    { LAS unsigned char* stg = gl + qb * 12288;
      LAS unsigned char* st = stg + r * 272 + hi * 8;
#pragma unroll
      for (int eb = 0; eb < 4; ++eb)
#pragma unroll
          for (int g = 0; g < 4; ++g) *(LAS u32x2*)(st + eb * 64 + 16 * g) = (u32x2){pk_bf16(o[eb][4 * g] * rn, o[eb][4 * g + 1] * rn), pk_bf16(o[eb][4 * g + 2] * rn, o[eb][4 * g + 3] * rn)};
      asm volatile("" ::: "memory");
      const int pc = lane & 15, rl = lane >> 4;
      const GAS bf16* gp = PA + PA_GR + ch * 16384 + (size_t)(pc >> 2) * 4096 + (size_t)(qb * 32 + rl) * 32 + (pc & 3) * 8;
      GAS bf16* yp = Y + (row0 + qb * 32 + rl) * 1024 + Y_RET + h * 128 + pc * 8;
      u32x4 gv[8];
#pragma unroll
      for (int i = 0; i < 8; ++i) gv[i] = *(const GAS u32x4*)(gp + (size_t)i * 4 * 32);
#pragma unroll
      for (int i = 0; i < 8; ++i) { const u32x4 ov = *(const LAS u32x4*)(stg + (4 * i + rl) * 272 + pc * 16); u32x4 w;
#pragma unroll
          for (int q = 0; q < 4; ++q) w[q] = pk_bf16(bf_lo(ov[q]) * bf_lo(gv[i][q]), bf_hi(ov[q]) * bf_hi(gv[i][q]));
          *(GAS u32x4*)(yp + (size_t)i * 4 * 1024) = w; }
      asm volatile("" ::: "memory"); }
}

template <int W> __device__ __forceinline__ void pool_run(const bf16* PA_, bf16* Y_, int g, int rbg, int lane) {
    const GAS bf16* PA = (const GAS bf16*)PA_; GAS bf16* Y = (GAS bf16*)Y_;
    const int c8 = lane & 7, row0 = (rbg * 8 + (lane >> 3)) * 8, t0 = row0 & (SEQ - 1);
    const GAS bf16* up = PA + PA_UP + (size_t)row0 * 256 + g * 64 + c8 * 8;
    u32x4 v[W + 7];
#pragma unroll
    for (int j = 0; j < W + 7; ++j) { const int dt = j - (W - 1); v[j] = (t0 + dt >= 0) ? *(const GAS u32x4*)(up + (ptrdiff_t)dt * 256) : (u32x4){0u, 0u, 0u, 0u}; }
    float S[8];
#pragma unroll
    for (int k = 0; k < 8; ++k) S[k] = 0.f;
#pragma unroll
    for (int j = 0; j < W; ++j)
#pragma unroll
        for (int k = 0; k < 4; ++k) { S[2 * k] += bf_lo(v[j][k]); S[2 * k + 1] += bf_hi(v[j][k]); }
    GAS bf16* yp = Y + (size_t)row0 * 1024 + Y_POOL + g * 64 + c8 * 8;
#pragma unroll
    for (int i = 0; i < 8; ++i) {
        if (i > 0) {
#pragma unroll
            for (int k = 0; k < 4; ++k) { S[2 * k] += bf_lo(v[W - 1 + i][k]) - bf_lo(v[i - 1][k]); S[2 * k + 1] += bf_hi(v[W - 1 + i][k]) - bf_hi(v[i - 1][k]); } }
        const int cnt = (t0 + i + 1 < W) ? t0 + i + 1 : W; const float inv = 1.0f / (float)cnt; unsigned o[4];
#pragma unroll
        for (int k = 0; k < 4; ++k) o[k] = pk_bf16(S[2 * k] * inv - bf_lo(v[W - 1 + i][k]), S[2 * k + 1] * inv - bf_hi(v[W - 1 + i][k]));
        *(GAS u32x4*)(yp + (size_t)i * 1024) = (u32x4){o[0], o[1], o[2], o[3]};
    }
}


__device__ __forceinline__ size_t wblk(int n, int k, int nt) { return ((((size_t)(n >> 8) * nt + (k >> 6)) * 2 + ((k >> 5) & 1)) * 256 + (n & 255)) * 32 + (k & 31); }
__device__ __forceinline__ int rho32(int n0) { const int w = n0 & 255; return (n0 & ~255) + ((w >> 5) & 3) * 64 + (w >> 7) * 32; }
__device__ __forceinline__ void tr_item(const float* src_, int ldsrc, int k0, int c0, bf16* dst_, int n0, int nt, int koff, float scale, const float* gain_, LAS float* scr, int lane) {
    const GAS float* src = (const GAS float*)src_; GAS bf16* dst = (GAS bf16*)dst_; const GAS float* gain = (const GAS float*)gain_;
    const int rr = lane >> 3, cc = (lane & 7) * 4;
    f32x4 v[8]; float gk[8];
#pragma unroll
    for (int i = 0; i < 8; ++i) { const int kk = 8 * i + rr; v[i] = *(const GAS f32x4*)(src + (size_t)(k0 + kk) * ldsrc + c0 + cc); gk[i] = gain ? gain[k0 + kk] : 1.0f; }
#pragma unroll
    for (int i = 0; i < 8; ++i) { const int kk = 8 * i + rr; const float s = scale * gk[i]; LAS float* p = scr + kk * 33 + cc; p[0] = v[i][0] * s; p[1] = v[i][1] * s; p[2] = v[i][2] * s; p[3] = v[i][3] * s; }
    asm volatile("s_waitcnt lgkmcnt(0)" ::: "memory");
    const int c = lane & 7;
#pragma unroll
    for (int j = 0; j < 4; ++j) { const int n = (lane >> 3) + 8 * j; const LAS float* s = scr + (8 * c) * 33 + n;
        const u32x4 o = {pk_bf16(s[0 * 33], s[1 * 33]), pk_bf16(s[2 * 33], s[3 * 33]), pk_bf16(s[4 * 33], s[5 * 33]), pk_bf16(s[6 * 33], s[7 * 33])};
        *(GAS u32x4*)(dst + wblk(n0 + n, koff + k0 + 8 * c, nt)) = o; }
    asm volatile("s_waitcnt lgkmcnt(0)" ::: "memory");
}
__device__ __forceinline__ void convert_weights(const LAS unsigned long long* PTAB, int l, unsigned char* wsw, LAS float* scr, int gw, int NGW, int gt, int NT, int lane) {
    bf16* W13A = (bf16*)(wsw + W_13A); bf16* W2A = (bf16*)(wsw + W_2A); bf16* WIN = (bf16*)(wsw + W_IN); bf16* WB = (bf16*)(wsw + W_B); bf16* WOUT = (bf16*)(wsw + W_OUT); bf16* W13B = (bf16*)(wsw + W_13B); bf16* W2B = (bf16*)(wsw + W_2B);
    constexpr int I_13 = 16 * 176, I_2 = 44 * 32, I_IN = 16 * 176, I_SB = 4 * 32, I_RET = 8 * 32, I_OUT = 16 * 32;
    constexpr int NITEMS = 2 * I_13 + 2 * I_2 + I_IN + I_SB + I_RET + I_OUT;
    for (int it = gw; it < NITEMS; it += NGW) {
        int q = it;
        if (q < 2 * I_13) {
            const bool second = q >= I_13; if (second) q -= I_13;
            const int kb = q / 176, nb = q % 176, n0 = 32 * nb, pn = n0 >> 8, bj = (n0 >> 7) & 1, j0 = n0 & 127;
            const float* src = second ? (bj ? (((const float*)PTAB[15]) + (size_t)l * DM * DFF) : (((const float*)PTAB[14]) + (size_t)l * DM * DFF)) : (bj ? (((const float*)PTAB[3]) + (size_t)l * DM * DFF) : (((const float*)PTAB[2]) + (size_t)l * DM * DFF));
            tr_item(src, DFF, 64 * kb, 128 * pn + j0, (second ? W13B : W13A), n0, 16, 0, 1.0f, second ? (((const float*)PTAB[13]) + (size_t)l * DM) : (((const float*)PTAB[1]) + (size_t)l * DM), scr, lane); continue; }
        q -= 2 * I_13;
        if (q < 2 * I_2) {
            const bool second = q >= I_2; if (second) q -= I_2;
            const int kb = q / 32, nb = q % 32;
            tr_item(second ? (((const float*)PTAB[16]) + (size_t)l * DFF * DM) : (((const float*)PTAB[4]) + (size_t)l * DFF * DM), 1024, 64 * kb, rho32(32 * nb), (second ? W2B : W2A), 32 * nb, 44, 0, 0.5f, nullptr, scr, lane); continue; }
        q -= 2 * I_2;
        if (q < I_IN) {
            const int kb = q / 176, nb = q % 176, n0 = 32 * nb; int c0 = n0; float sc = 1.0f;
            if (n0 >= 768 && n0 < 1280) { const int T = n0 >> 8, wi = n0 & 255, bj = wi >> 7, hd = (wi >> 5) & 3; c0 = T * 256 + 64 * hd + 32 * bj; }
            if (n0 >= 2560) c0 = 2560 + rho32(n0 - 2560);
            if (n0 < 256) sc = 0.125f * 1.4426950408889634f; else if (n0 >= 1024 && n0 < 1280) sc = 0.125f; else if (n0 >= 2560) sc = -1.4426950408889634f;
            tr_item((((const float*)PTAB[6]) + (size_t)l * DM * DIN), DIN, 64 * kb, c0, WIN, n0, 16, 0, sc, (((const float*)PTAB[5]) + (size_t)l * DM), scr, lane); continue; }
        q -= I_IN;
        if (q < I_SB) { const int kb = q / 32, nb = q % 32; tr_item((((const float*)PTAB[7]) + (size_t)l * 256 * DM), 1024, 64 * kb, rho32(32 * nb), WB, 32 * nb, 16, Y_SB, 1.0f, nullptr, scr, lane); continue; }
        q -= I_SB;
        if (q < I_RET) { const int kb = q / 32, nb = q % 32; tr_item((((const float*)PTAB[8]) + (size_t)l * 512 * DM), 1024, 64 * kb, rho32(32 * nb), WB, 32 * nb, 16, Y_RET, 1.0f, nullptr, scr, lane); continue; }
        q -= I_RET;
        { const int kb = q / 32, nb = q % 32; tr_item((((const float*)PTAB[12]) + (size_t)l * DM * DM), 1024, 64 * kb, rho32(32 * nb), WOUT, 32 * nb, 16, 0, 1.0f, nullptr, scr, lane); }
    }
    {
        typedef const __attribute__((address_space(4))) float* cfp;
        for (int idx = gt; idx < 256 * 1024; idx += NT) {
            const int n = idx & 1023, kc = __builtin_amdgcn_readfirstlane(idx >> 10), g = kc >> 6;
            const GAS float* bp = (const GAS float*)(((const float*)PTAB[9]) + (size_t)l * 256 * DM) + (size_t)(g * 64) * 1024 + rho32(n & ~31) + (n & 31);
            cfp ap = (cfp)(((const float*)PTAB[10]) + (size_t)l * 4 * 64 * 64 + (size_t)kc * 64); cfp sp = (cfp)(((const float*)PTAB[11]) + (size_t)l * 256 + g * 64);
            float b[64];
#pragma unroll
            for (int e = 0; e < 64; ++e) b[e] = bp[(size_t)e * 1024];
            float s = 0.f;
#pragma unroll
            for (int e = 0; e < 64; ++e) s += ap[e] * sp[e] * b[e];
            ((GAS bf16*)WB)[wblk(n, Y_POOL + kc, 16)] = (bf16)(pk_bf16(s, 0.f) & 0xffffu);
        }
    }
}
__device__ const double c_invf[32] = {1.0, 0.7498942093324559, 0.5623413251903491, 0.4216965034285822, 0.31622776601683794, 0.23713737056616552, 0.1778279410038923, 0.1333521432163324, 0.1, 0.07498942093324558, 0.05623413251903491, 0.042169650342858224, 0.03162277660168379, 0.023713737056616554, 0.01778279410038923, 0.01333521432163324, 0.01, 0.007498942093324558, 0.005623413251903491, 0.004216965034285823, 0.0031622776601683794, 0.0023713737056616554, 0.0017782794100389228, 0.001333521432163324, 0.001, 0.0007498942093324559, 0.0005623413251903491, 0.00042169650342858224, 0.00031622776601683794, 0.00023713737056616554, 0.00017782794100389227, 0.0001333521432163324};
__device__ __forceinline__ void rope_entry(int pos, int i, float* out) {
    const double* invp = c_invf; asm volatile("" : "+v"(invp));
    const double a = (double)pos * invp[i];
    const double n = __builtin_rint(a * 0.63661977236758134308);
    double y = __builtin_fma(-n, 1.57079632673412561417e+00, a); y = __builtin_fma(-n, 6.07710050650619224932e-11, y);
    const double y2 = y * y;
    const double sp = y * (1.0 + y2 * (-1.0 / 6.0 + y2 * (1.0 / 120.0 + y2 * (-1.0 / 5040.0 + y2 * (1.0 / 362880.0 + y2 * (-1.0 / 39916800.0 + y2 * (1.0 / 6227020800.0)))))));
    const double cp = 1.0 + y2 * (-0.5 + y2 * (1.0 / 24.0 + y2 * (-1.0 / 720.0 + y2 * (1.0 / 40320.0 + y2 * (-1.0 / 3628800.0 + y2 * (1.0 / 479001600.0 + y2 * (-1.0 / 87178291200.0)))))));
    const int q = ((int)n) & 3;
    const double s = (q == 0) ? sp : (q == 1) ? cp : (q == 2) ? -sp : -cp, c = (q == 0) ? cp : (q == 1) ? -sp : (q == 2) ? -cp : sp;
    out[0] = (float)c; out[1] = (float)s;
}

#ifndef MK_IP_PROBE
#define MK_IP_PROBE 0
#endif
#ifndef MK_UP_PROBE
#define MK_UP_PROBE 0
#endif
#ifndef MK_NULL_MASK
#define MK_NULL_MASK 0
#endif
#ifndef MK_DOUBLE_MASK
#define MK_DOUBLE_MASK 0
#endif
#ifndef MK_P4_SB_REPS
#define MK_P4_SB_REPS 1
#endif
#ifndef MK_P4_SB_FORCE
#define MK_P4_SB_FORCE 0
#endif
#ifndef MK_P4_KV_REPS
#define MK_P4_KV_REPS 1
#endif
#ifndef MK_SCAN_DEPTH
#define MK_SCAN_DEPTH 128
#endif
#ifndef MK_P4_REPS
#define MK_P4_REPS 1
#endif
#ifndef MK_P4_STAGGER
#define MK_P4_STAGGER 0
#endif
#ifndef MK_P5_REPS
#define MK_P5_REPS 1
#endif
#ifndef MK_P6_REPS
#define MK_P6_REPS 1
#endif
constexpr int PH_PER_LAYER = 11, N_PHASES = DEPTH * PH_PER_LAYER + 1;
struct Args { const float* in[18]; float* out; unsigned char* ws; int ph_lo, ph_hi; };
__global__ void __launch_bounds__(NWAVES * 64, 2) mk_fwd(Args args) {
    extern __shared__ __attribute__((aligned(16))) unsigned char lds_raw[];
    LAS unsigned char* lds = (LAS unsigned char*)lds_raw;
    volatile LAS unsigned* MISC = (volatile LAS unsigned*)(lds + MISC_OFF);
    const int tid0 = threadIdx.x, wave = __builtin_amdgcn_readfirstlane(tid0 >> 6);
    const int G = gridDim.x; const int vcu = (G % 8 == 0) ? ((int)blockIdx.x % 8) * (G / 8) + (int)blockIdx.x / 8 : (int)blockIdx.x;
    const int gw = vcu * NWAVES + wave, NGW = G * NWAVES, NT = G * NWAVES * 64;
    unsigned char* const ws0 = args.ws;
#define SSQ ((float*)(ws + WS_SSQ))
#define ROPE ((float*)(ws + WS_ROPE))
#define XB ((bf16*)(ws + WS_XB))
#define Y ((bf16*)xout)
#define PA ((bf16*)(ws + WS_PA))
#define PG ((bf16*)(ws + WS_PG))
#define ACT ((bf16*)(ws + WS_ACT))
#define MRG ((bf16*)(ws + WS_MRG))
#define KV ((float*)(ws + WS_KV))
#define STATE ((bf16*)(ws + WS_STATE))
#define wsw (ws + WS_W)
    LAS unsigned char* wl = lds + wave * 16384;
    for (int u = tid0; u < 32; u += NWAVES * 64) MISC[u] = 0u;
    LAS unsigned long long* PTAB = (LAS unsigned long long*)(lds + MISC_OFF + 128);
    if (tid0 < 18) PTAB[tid0] = ((const __attribute__((address_space(4))) unsigned long long*)__builtin_amdgcn_kernarg_segment_ptr())[tid0];
    __syncthreads();
    const int lo = args.ph_lo, hi = args.ph_hi;
    XcdBarrier bar; bar.bar = (unsigned*)(ws0 + WS_CTL); bar.x = 0; bar.st = nullptr;
    if (hi - lo > 1) bar = xcd_barrier_post((unsigned*)(ws0 + WS_CTL), MISC + 8);
#define IN(k) (lo <= (k) && (k) < hi)
#ifdef MK_DOUBLE_BARRIER
#define SEAM(k) do { if (IN(k) && IN((k) + 1)) { xcd_barrier(bar); xcd_barrier(bar); } } while (0)
#else
#define SEAM(k) do { if (IN(k) && IN((k) + 1)) xcd_barrier(bar); } while (0)
#endif

    if (IN(0)) {
        unsigned char* ws = ws0; float* xout = args.out; int tid = tid0; asm volatile("" : "+s"(ws), "+s"(xout), "+v"(tid)); const int lane = tid & 63, gt = vcu * (NWAVES * 64) + tid;
                const float* xin = (const float*)PTAB[0];
            for (int row = gw; row < M; row += NGW) {
                const f32x4* xr = (const f32x4*)(xin + (size_t)row * DM) + lane; u32x2* bo = (u32x2*)(XB + (size_t)row * DM) + lane;
                float ss = 0.f;
#pragma unroll
                for (int j = 0; j < 4; ++j) { const f32x4 v = xr[64 * j]; bo[64 * j] = (u32x2){pk_bf16(v[0], v[1]), pk_bf16(v[2], v[3])}; ss += (v[0] * v[0] + v[1] * v[1]) + (v[2] * v[2] + v[3] * v[3]); }
                ss = wave_sum(ss);
                if (lane == 0) *(f32x4*)(SSQ + (size_t)row * 4) = (f32x4){ss, 0.f, 0.f, 0.f};
            }
            for (int idx = gt; idx < SEQ * 32; idx += NT) { const int i = idx & 31; rope_entry(idx >> 5, i, ROPE + ((size_t)(idx & ~31) + ((i >> 1) & 3) * 8 + (i >> 3) * 2 + (i & 1)) * 2); }
            }
    for (int l = 0; l < DEPTH; ++l) {
        const int pb = l * PH_PER_LAYER;
        if (IN(pb + 0)) for (int rep_ = 0; rep_ < (((MK_DOUBLE_MASK >> 0) & 1) ? 2 : 1); ++rep_) {
            unsigned char* ws = ws0; float* xout = args.out; int tid = tid0; asm volatile("" : "+s"(ws), "+s"(xout), "+v"(tid)); const int lane = tid & 63, gt = vcu * (NWAVES * 64) + tid; (void)lane; (void)gt;
            convert_weights(PTAB, l, ws + WS_W, (LAS float*)wl, gw, NGW, gt, NT, lane);
        }
        SEAM(pb + 0);
        if (IN(pb + 1)) for (int rep_ = 0; rep_ < (((MK_DOUBLE_MASK >> 1) & 1) ? 2 : 1); ++rep_) {
            unsigned char* ws = ws0; float* xout = args.out; int tid = tid0; asm volatile("" : "+s"(ws), "+s"(xout), "+v"(tid)); const int lane = tid & 63, gt = vcu * (NWAVES * 64) + tid; (void)lane; (void)gt;
            pg8::Gemm g{XB, (const bf16*)(wsw + W_13A), M, DIN, DM}; pg8::StaticOrder S; S.init(M, DIN, G, (int)blockIdx.x);
            pg8::EpiUp E{ACT, SSQ, (LAS float*)(lds + PSTAT_OFF)};
#if MK_UP_PROBE
            { pg8::EpiUpT<MK_UP_PROBE> EP{ACT, SSQ, (LAS float*)(lds + PSTAT_OFF)}; pg8::gemm_phase<pg8::EpiUpT<MK_UP_PROBE>, pg8::StaticOrder, true, true>(lds, g, S, EP); }
#endif
            if ((MK_NULL_MASK >> 1) & 1) { pg8::EpiNull EN; pg8::gemm_phase<pg8::EpiNull, pg8::StaticOrder, true, true>(lds, g, S, EN); }
            pg8::gemm_phase<pg8::EpiUp, pg8::StaticOrder, true, true>(lds, g, S, E);
        }
        SEAM(pb + 1);
        if (IN(pb + 2)) for (int rep_ = 0; rep_ < (((MK_DOUBLE_MASK >> 2) & 1) ? 2 : 1); ++rep_) {
            unsigned char* ws = ws0; float* xout = args.out; int tid = tid0; asm volatile("" : "+s"(ws), "+s"(xout), "+v"(tid)); const int lane = tid & 63, gt = vcu * (NWAVES * 64) + tid; (void)lane; (void)gt;
            pg8::Gemm g{ACT, (const bf16*)(wsw + W_2A), M, DM, DFF}; pg8::StaticOrder S; S.init(M, DM, G, (int)blockIdx.x);
            if (l == 0) { pg8::EpiResid<true> E{(const void*)PTAB[0], XB, SSQ, (LAS float*)(lds + PSTAT_OFF)};
                pg8::gemm_phase<pg8::EpiResid<true>, pg8::StaticOrder, true, true, true>(lds, g, S, E); }
            else { pg8::EpiResid<false> E{XB, XB, SSQ, (LAS float*)(lds + PSTAT_OFF)};
                pg8::gemm_phase<pg8::EpiResid<false>, pg8::StaticOrder, true, true, true>(lds, g, S, E); }
        }
        SEAM(pb + 2);
        if (IN(pb + 3)) for (int rep_ = 0; rep_ < (((MK_DOUBLE_MASK >> 3) & 1) ? 2 : 1); ++rep_) {
            unsigned char* ws = ws0; float* xout = args.out; int tid = tid0; asm volatile("" : "+s"(ws), "+s"(xout), "+v"(tid)); const int lane = tid & 63, gt = vcu * (NWAVES * 64) + tid; (void)lane; (void)gt;
            pg8::Gemm g{XB, (const bf16*)(wsw + W_IN), M, DIN, DM}; pg8::StaticOrder S; S.init(M, DIN, G, (int)blockIdx.x);
            pg8::EpiInProj E{PA, PG, SSQ, ROPE, (LAS float*)(lds + PSTAT_OFF)};
#if MK_IP_PROBE
            { pg8::EpiInProjT<MK_IP_PROBE> EP{PA, PG, SSQ, ROPE, (LAS float*)(lds + PSTAT_OFF)}; pg8::gemm_phase<pg8::EpiInProjT<MK_IP_PROBE>, pg8::StaticOrder, true, true>(lds, g, S, EP); }
#endif
            if ((MK_NULL_MASK >> 3) & 1) { pg8::EpiNull EN; pg8::gemm_phase<pg8::EpiNull, pg8::StaticOrder, true, true>(lds, g, S, EN); }
            pg8::gemm_phase<pg8::EpiInProj, pg8::StaticOrder, true, true>(lds, g, S, E);
        }
        SEAM(pb + 3);
        if (IN(pb + 4)) for (int rep_ = 0; rep_ < (((MK_DOUBLE_MASK >> 4) & 1) ? 2 : 1); ++rep_) {
            unsigned char* ws = ws0; float* xout = args.out; int tid = tid0; asm volatile("" : "+s"(ws), "+s"(xout), "+v"(tid)); const int lane = tid & 63, gt = vcu * (NWAVES * 64) + tid; (void)lane; (void)gt;
            for (int rp4_ = 0; rp4_ < MK_P4_REPS; ++rp4_) {
                for (int r4_ = 0; r4_ < MK_P4_SB_REPS; ++r4_) for (int it = gw; it < BATCH * 4 * (SEQ / 32); it += NGW) sb_item(PA, Y, wl, it >> 11, (it >> 9) & 3, it & 511, lane, r4_ + 1 < MK_P4_SB_REPS ? MK_P4_SB_FORCE : 0);
                for (int r4_ = 0; r4_ < MK_P4_KV_REPS; ++r4_) kv_group(PA, KV, lds, vcu, G, wave, lane);
            }
        }
        SEAM(pb + 4);
        if (IN(pb + 5)) for (int rep_ = 0; rep_ < MK_P5_REPS * ((((MK_DOUBLE_MASK >> 5) & 1) ? 2 : 1)); ++rep_) {
            unsigned char* ws = ws0; float* xout = args.out; int tid = tid0; asm volatile("" : "+s"(ws), "+s"(xout), "+v"(tid)); const int lane = tid & 63, gt = vcu * (NWAVES * 64) + tid; (void)lane; (void)gt;
            for (int el = gt; el < BATCH * 4 * 4096; el += NT) {
                const int b = el >> 14, h = (el >> 12) & 3, ed = (el & 4095) * 2;
                const float dk = __builtin_amdgcn_exp2f(128.0f * l2gamma(h));
                const size_t base = ((size_t)(b * NCHUNK) * 4 + h) * 8192 + ed;
                float S0 = 0.f, S1 = 0.f;
                const GAS unsigned* kvp = (const GAS unsigned*)((const GAS bf16*)KV + base); GAS unsigned* stp = (GAS unsigned*)((GAS bf16*)STATE + base);
#pragma unroll 1
                for (int n0 = 0; n0 < NCHUNK; n0 += MK_SCAN_DEPTH) { unsigned v[MK_SCAN_DEPTH];
#pragma unroll
                    for (int j = 0; j < MK_SCAN_DEPTH; ++j) v[j] = kvp[(size_t)(n0 + j) * 16384];
#pragma unroll
                    for (int j = 0; j < MK_SCAN_DEPTH; ++j) { stp[(size_t)(n0 + j) * 16384] = pk_bf16(S0, S1); S0 = S0 * dk + bf_lo(v[j]); S1 = S1 * dk + bf_hi(v[j]); } }
            }
            if (gw >= NGW / 4) for (int wi = gw - NGW / 4; wi < 4 * (M / 64); wi += NGW - NGW / 4) { const int g = wi & 3, rbg = wi >> 2;
              { if (g == 0) pool_run<2>(PA, Y, 0, rbg, lane); else if (g == 1) pool_run<4>(PA, Y, 1, rbg, lane); else if (g == 2) pool_run<8>(PA, Y, 2, rbg, lane); else pool_run<16>(PA, Y, 3, rbg, lane); } }
        }
        SEAM(pb + 5);
        if (IN(pb + 6)) for (int rep_ = 0; rep_ < (((MK_DOUBLE_MASK >> 6) & 1) ? 2 : 1); ++rep_) {
            unsigned char* ws = ws0; float* xout = args.out; int tid = tid0; asm volatile("" : "+s"(ws), "+s"(xout), "+v"(tid)); const int lane = tid & 63, gt = vcu * (NWAVES * 64) + tid; (void)lane; (void)gt;
            for (int r6_ = 0; r6_ < MK_P6_REPS; ++r6_) for (int cp = vcu; cp < BATCH * NCHUNK * 4 / 2; cp += G) ret_group(PA, STATE, Y, lds, cp, wave, lane);
        }
        SEAM(pb + 6);
        if (IN(pb + 7)) for (int rep_ = 0; rep_ < (((MK_DOUBLE_MASK >> 7) & 1) ? 2 : 1); ++rep_) {
            unsigned char* ws = ws0; float* xout = args.out; int tid = tid0; asm volatile("" : "+s"(ws), "+s"(xout), "+v"(tid)); const int lane = tid & 63, gt = vcu * (NWAVES * 64) + tid; (void)lane; (void)gt;
            pg8::Gemm g{Y, (const bf16*)(wsw + W_B), M, DM, DM}; pg8::StaticOrder S; S.init(M, DM, G, (int)blockIdx.x);
            pg8::EpiMerge E{MRG, PG};
            if ((MK_NULL_MASK >> 7) & 1) { pg8::EpiNull EN; pg8::gemm_phase<pg8::EpiNull, pg8::StaticOrder, true, true>(lds, g, S, EN); }
            pg8::gemm_phase<pg8::EpiMerge, pg8::StaticOrder, true, true>(lds, g, S, E);
        }
        SEAM(pb + 7);
        if (IN(pb + 8)) for (int rep_ = 0; rep_ < (((MK_DOUBLE_MASK >> 8) & 1) ? 2 : 1); ++rep_) {
            unsigned char* ws = ws0; float* xout = args.out; int tid = tid0; asm volatile("" : "+s"(ws), "+s"(xout), "+v"(tid)); const int lane = tid & 63, gt = vcu * (NWAVES * 64) + tid; (void)lane; (void)gt;
            pg8::Gemm g{MRG, (const bf16*)(wsw + W_OUT), M, DM, DM}; pg8::StaticOrder S; S.init(M, DM, G, (int)blockIdx.x);
            pg8::EpiResid<false> E{XB, XB, SSQ, (LAS float*)(lds + PSTAT_OFF)};
            if ((MK_NULL_MASK >> 8) & 1) { pg8::EpiNull EN; pg8::gemm_phase<pg8::EpiNull, pg8::StaticOrder, true, true>(lds, g, S, EN); }
            pg8::gemm_phase<pg8::EpiResid<false>, pg8::StaticOrder, true, true>(lds, g, S, E);
        }
        SEAM(pb + 8);
        if (IN(pb + 9)) for (int rep_ = 0; rep_ < (((MK_DOUBLE_MASK >> 9) & 1) ? 2 : 1); ++rep_) {
            unsigned char* ws = ws0; float* xout = args.out; int tid = tid0; asm volatile("" : "+s"(ws), "+s"(xout), "+v"(tid)); const int lane = tid & 63, gt = vcu * (NWAVES * 64) + tid; (void)lane; (void)gt;
            pg8::Gemm g{XB, (const bf16*)(wsw + W_13B), M, DIN, DM}; pg8::StaticOrder S; S.init(M, DIN, G, (int)blockIdx.x);
            pg8::EpiUp E{ACT, SSQ, (LAS float*)(lds + PSTAT_OFF)};
#if MK_UP_PROBE
            { pg8::EpiUpT<MK_UP_PROBE> EP{ACT, SSQ, (LAS float*)(lds + PSTAT_OFF)}; pg8::gemm_phase<pg8::EpiUpT<MK_UP_PROBE>, pg8::StaticOrder, true, true>(lds, g, S, EP); }
#endif
            if ((MK_NULL_MASK >> 9) & 1) { pg8::EpiNull EN; pg8::gemm_phase<pg8::EpiNull, pg8::StaticOrder, true, true>(lds, g, S, EN); }
            pg8::gemm_phase<pg8::EpiUp, pg8::StaticOrder, true, true>(lds, g, S, E);
        }
        SEAM(pb + 9);
        if (IN(pb + 10)) for (int rep_ = 0; rep_ < (((MK_DOUBLE_MASK >> 10) & 1) ? 2 : 1); ++rep_) {
            unsigned char* ws = ws0; float* xout = args.out; int tid = tid0; asm volatile("" : "+s"(ws), "+s"(xout), "+v"(tid)); const int lane = tid & 63, gt = vcu * (NWAVES * 64) + tid; (void)lane; (void)gt;
            pg8::Gemm g{ACT, (const bf16*)(wsw + W_2B), M, DM, DFF}; pg8::StaticOrder S; S.init(M, DM, G, (int)blockIdx.x);
            pg8::EpiResid<false> E{XB, XB, SSQ, (LAS float*)(lds + PSTAT_OFF)};
            if ((MK_NULL_MASK >> 10) & 1) { pg8::EpiNull EN; pg8::gemm_phase<pg8::EpiNull, pg8::StaticOrder, true, true, true>(lds, g, S, EN); }
            pg8::gemm_phase<pg8::EpiResid<false>, pg8::StaticOrder, true, true, true>(lds, g, S, E);
        }
        SEAM(pb + 10);
    }
#ifdef MK_DUMP_OFF
    if (IN(N_PHASES - 1)) {
        const unsigned char* ws = ws0; float* xout = args.out;
        for (int i = vcu * 512 + tid0; i < M * 1024; i += NT) { const int row = i >> 10, c = i & 1023; float s = 0.f;
            for (int cc = c + MK_DUMP_C0; cc < MK_DUMP_C1; cc += 1024) { const float v_ = MK_DUMP_F32 ? ((const float*)(ws + MK_DUMP_OFF))[(size_t)row * MK_DUMP_W + cc] : bf_lo((unsigned)((const bf16*)(ws + MK_DUMP_OFF))[(size_t)row * MK_DUMP_W + cc]); s += (v_ != v_) ? 1000.f : (__builtin_fabsf(v_) > 1e30f ? 2000.f : v_); }
            xout[i] = s; }
    }
#else
    if (IN(N_PHASES - 1)) {
        unsigned char* ws = ws0; float* xout = args.out; int tid = tid0; asm volatile("" : "+s"(ws), "+s"(xout), "+v"(tid)); const int lane = tid & 63, gt = vcu * (NWAVES * 64) + tid; (void)lane; (void)gt;
        const float* gf = (const float*)PTAB[17];
        for (int row = gw; row < M; row += NGW) {
            const float rs = pg8::row_rs(SSQ, row); f32x4* xo = (f32x4*)(xout + (size_t)row * DM) + lane; const f32x4* gp = (const f32x4*)gf + lane; const u32x2* xb = (const u32x2*)(XB + (size_t)row * DM) + lane;
#pragma unroll
            for (int j = 0; j < 4; ++j) { const u32x2 x = xb[64 * j]; xo[64 * j] = (f32x4){bf_lo(x[0]), bf_hi(x[0]), bf_lo(x[1]), bf_hi(x[1])} * rs * gp[64 * j]; }
        }
    }
#endif
#undef IN
#undef SEAM
#undef SSQ
#undef ROPE
#undef XB
#undef Y
#undef PA
#undef PG
#undef ACT
#undef MRG
#undef KV
#undef STATE
#undef wsw
}

#ifndef MK_PER_PHASE
#define MK_PER_PHASE 0
#endif
extern "C" void kernel_launch(void* const* d_in, const int* in_sizes, int n_in, void* d_out, int out_size, void* d_ws, size_t ws_size, hipStream_t stream) {
    static int grid = 0;
    if (grid == 0) {
        if (n_in != 18 || in_sizes[0] != M * DM || out_size != M * DM || ws_size < WS_END) { fprintf(stderr, "kernel_launch: unexpected shapes (n_in %d, in0 %d, out %d, ws %zu); nothing launched\n", n_in, n_in > 0 ? in_sizes[0] : -1, out_size, ws_size); grid = -1; return; }
        int dev = 0, cus = 0, per_cu = 0;
        if (hipGetDevice(&dev) != hipSuccess || hipDeviceGetAttribute(&cus, hipDeviceAttributeMultiprocessorCount, dev) != hipSuccess) { grid = -1; return; }
        if (hipFuncSetAttribute((const void*)mk_fwd, hipFuncAttributeMaxDynamicSharedMemorySize, LDS_BYTES) != hipSuccess) { fprintf(stderr, "kernel_launch: hipFuncSetAttribute failed\n"); grid = -1; return; }
        if (hipOccupancyMaxActiveBlocksPerMultiprocessor(&per_cu, (const void*)mk_fwd, NWAVES * 64, LDS_BYTES) != hipSuccess || per_cu < 1) fprintf(stderr, "kernel_launch: note: occupancy query says %d\n", per_cu);
        (void)hipGetLastError();
        grid = cus;
    }
    if (grid < 0) return;
    (void)hipMemsetAsync((char*)d_ws + WS_CTL, 0, CTL_ZERO_BYTES, stream);
    Args a{};
    for (int i = 0; i < 18; ++i) a.in[i] = (const float*)d_in[i];
    a.out = (float*)d_out; a.ws = (unsigned char*)d_ws;
#if MK_PER_PHASE
    for (int p = 0; p < N_PHASES; ++p) {
#ifdef MK_STOP_AFTER
        if (p > MK_STOP_AFTER && p != N_PHASES - 1) continue;
#ifdef MK_SKIP_MASK
        if ((MK_SKIP_MASK >> p) & 1) continue;
#endif
#endif
        a.ph_lo = p; a.ph_hi = p + 1; hipLaunchKernelGGL(mk_fwd, dim3(grid), dim3(NWAVES * 64), LDS_BYTES, stream, a); }
#else
    a.ph_lo = 0; a.ph_hi = N_PHASES; hipLaunchKernelGGL(mk_fwd, dim3(grid), dim3(NWAVES * 64), LDS_BYTES, stream, a);
#endif
    const hipError_t le = hipPeekAtLastError();
    if (le != hipSuccess) fprintf(stderr, "kernel_launch: launch failed: %s\n", hipGetErrorName(le));
}
```

```cpp
#include <hip/hip_runtime.h>
#include <cstdio>
#include <cstdint>

namespace pg8 {
#define PG8_LAS __attribute__((address_space(3)))
typedef unsigned short bf16_t;
typedef short bf16x8 __attribute__((ext_vector_type(8)));
typedef float f32x4 __attribute__((ext_vector_type(4)));
typedef unsigned u32x4 __attribute__((ext_vector_type(4)));
constexpr int BM = 256, BK = 64, HALF = 128, HTB = HALF * BK * 2  , STAGE_BYTES = 8 * HTB, NXCD = 8, WGM = 8;

__host__ __device__ __forceinline__ int lds_byte(int r, int c) { const int st = (r >> 4) * 2 + (c >> 5), rr = r & 15, cc = c & 31, ob = rr * 64 + cc * 2; return st * 1024 + (ob ^ (((ob >> 9) & 1) << 5)); }
__host__ __device__ __forceinline__ void stage_rc(int b, int& R, int& C) { const int st = b / 1024, sb = b % 1024, swz = sb ^ (((sb >> 9) & 1) << 5); R = (st >> 1) * 16 + swz / 64; C = (st & 1) * 32 + (swz % 64) / 2; }
__host__ __device__ __forceinline__ int perm32(int rho) { const int n = rho >> 4, i = rho & 15; return 8 * (i >> 2) + 4 * n + (i & 3); }

struct Unit { int pm, pn; };
struct Gemm { const bf16_t* A; const bf16_t* Bt; int M, N, K; };

struct StaticOrder {
    int nM, nN, nwg, G, c;
    __host__ __device__ void init(int M, int N, int G_, int c_) { nM = M / BM; nN = N / BM; nwg = nM * nN; G = G_; c = c_; }
    __host__ __device__ bool next(int i, Unit& u) const {
        const long L = (long)i * G + c; if (L >= nwg) return false;
        int wgid = (int)L; { const int q = nwg / NXCD, r = nwg % NXCD, xcd = wgid % NXCD, off = wgid / NXCD; wgid = (xcd < r ? xcd * (q + 1) : r * (q + 1) + (xcd - r) * q) + off; }
        const int nig = WGM * nN, gid = wgid / nig, fm = gid * WGM, gsz = (nM - fm) < WGM ? (nM - fm) : WGM;
        u.pm = fm + ((wgid % nig) % gsz); u.pn = (wgid % nig) / gsz; return true;
    }
    __device__ __forceinline__ void a_ready(const Unit&) const {}
    __device__ __forceinline__ void done(const Unit&) const {}
};


typedef float f32x2 __attribute__((ext_vector_type(2)));
typedef __bf16 bf16x2_t __attribute__((ext_vector_type(2)));
typedef unsigned u32x2 __attribute__((ext_vector_type(2)));
typedef __amdgpu_buffer_rsrc_t rsrc_t;
__device__ __forceinline__ rsrc_t mkrsrc(const void* p, unsigned bytes) { return __builtin_amdgcn_make_buffer_rsrc((void*)p, 0, (int)bytes, 0x00020000); }
__device__ __forceinline__ u32x4 bl128(rsrc_t r, int voff, int soff) { return __builtin_amdgcn_raw_buffer_load_b128(r, voff, soff, 0); }
__device__ __forceinline__ f32x4 bl128f(rsrc_t r, int voff, int soff) { return __builtin_bit_cast(f32x4, __builtin_amdgcn_raw_buffer_load_b128(r, voff, soff, 0)); }
#ifndef MK_ST_AUX
#define MK_ST_AUX 0
#endif
__device__ __forceinline__ void bs128(rsrc_t r, u32x4 v, int voff, int soff) { __builtin_amdgcn_raw_buffer_store_b128(v, r, voff, soff, MK_ST_AUX); }
#ifndef MK_NT_MASK
#define MK_NT_MASK 3
#endif
__device__ __forceinline__ void bs128nt(rsrc_t r, u32x4 v, int voff, int soff) { __builtin_amdgcn_raw_buffer_store_b128(v, r, voff, soff, 2); }
__device__ __forceinline__ void bs64(rsrc_t r, u32x2 v, int voff, int soff) { __builtin_amdgcn_raw_buffer_store_b64(v, r, voff, soff, 0); }
__device__ __forceinline__ int vadd(int base, int c) { int r = base + c; asm volatile("" : "+v"(r)); return r; }
__device__ __forceinline__ unsigned pk_bf16(float lo, float hi) { f32x2 v = {lo, hi}; bf16x2_t b = __builtin_convertvector(v, bf16x2_t); return __builtin_bit_cast(unsigned, b); }
__device__ __forceinline__ float bf_lo(unsigned w) { return __builtin_bit_cast(float, w << 16); }
__device__ __forceinline__ float bf_hi(unsigned w) { return __builtin_bit_cast(float, w & 0xffff0000u); }
#ifndef MK_SCALAR_RS
#define MK_SCALAR_RS 0
#endif
constexpr float LOG2E = 1.4426950408889634f;
__device__ __forceinline__ float fmul1(float a, float b) { float r; asm("v_mul_f32 %0, %1, %2" : "=v"(r) : "v"(a), "v"(b)); return r; }
constexpr unsigned MROWS = 32768;
__device__ __forceinline__ float sigmoid_f(float v) { return __builtin_amdgcn_rcpf(1.0f + __builtin_amdgcn_exp2f(-v * LOG2E)); }
__device__ __forceinline__ float rs_of(const f32x4 s) { return __builtin_amdgcn_rsqf(((s[0] + s[1]) + (s[2] + s[3])) * (1.0f / 1024.0f) + 1e-6f); }
__device__ __forceinline__ float row_rs(const float* ssq, int row) { return rs_of(*(const f32x4*)(ssq + (size_t)row * 4)); }
__device__ __forceinline__ void load_rs8(const float* ssq, int row0, float (&rs)[2][4]) {
    const rsrc_t r = mkrsrc(ssq, MROWS * 16u); f32x4 s[2][4];
#pragma unroll
    for (int ai = 0; ai < 2; ++ai)
#pragma unroll
        for (int m = 0; m < 4; ++m) s[ai][m] = bl128f(r, row0 * 16 + (ai * HALF + m * 16) * 16, 0);
#pragma unroll
    for (int ai = 0; ai < 2; ++ai)
#pragma unroll
        for (int m = 0; m < 4; ++m) rs[ai][m] = rs_of(s[ai][m]);
}
__device__ __forceinline__ void rs8_table(const float* ssq, PG8_LAS float* rst, const Unit& u, int wr, int fr, bool newpm, float (&rs)[2][4]) {
    if (newpm) {
        if (threadIdx.x < 256) rst[threadIdx.x] = rs_of(*(const f32x4*)(ssq + (size_t)(u.pm * BM + (int)threadIdx.x) * 4));
        asm volatile("s_waitcnt lgkmcnt(0)" ::: "memory"); __builtin_amdgcn_s_barrier(); asm volatile("" ::: "memory");
    }
#pragma unroll
    for (int ai = 0; ai < 2; ++ai)
#pragma unroll
        for (int m = 0; m < 4; ++m) rs[ai][m] = rst[ai * HALF + wr * 64 + m * 16 + fr];
}
__device__ __forceinline__ float l2gamma(int h) { return h == 0 ? -0.04580368961312479f : h == 1 ? -0.02272007650008353f : h == 2 ? -0.011315313227834146f : -0.005646563141142063f; }

__device__ __forceinline__ u32x4 ror8(u32x4 v) { u32x4 r;
#pragma unroll
    for (int i = 0; i < 4; ++i) r[i] = (unsigned)__builtin_amdgcn_mov_dpp((int)v[i], 0x128, 0xf, 0xf, false);
    return r; }
__device__ __forceinline__ u32x4 sel4(bool c, u32x4 a, u32x4 b) { return (u32x4){c ? a[0] : b[0], c ? a[1] : b[1], c ? a[2] : b[2], c ? a[3] : b[3]}; }
__device__ __forceinline__ void line_pack(bool lo, u32x4 p0, u32x4 p1, u32x4& a, u32x4& b) { const u32x4 r1 = ror8(p1); a = sel4(lo, p0, r1); b = sel4(lo, r1, p0); }
__device__ __forceinline__ void line_unpack(bool lo, u32x4 a, u32x4 b, u32x4& p0, u32x4& p1) { p0 = sel4(lo, a, b); p1 = ror8(sel4(lo, b, a)); }

template <int MODE> struct EpiUpT {
    static constexpr bool PERM = true, AFTER_DRAIN = false, HAS_MID = false; static constexpr int MID0 = -1, MID1 = -1, NST = 8;
    bf16_t* O; const float* ssq; PG8_LAS float* rst;
    __device__ __forceinline__ void mid(f32x4 (&)[2][2][4][2], const Unit&, int, int, int, int, int) const {}
    __device__ __forceinline__ void operator()(const f32x4 (&acc)[2][2][4][2], const Unit& u, int wr, int wc, int fr, int fq, bool newpm) const {
        const int row0 = u.pm * BM + wr * 64 + fr, col0 = u.pn * 128 + wc * 32 + 8 * fq;
        float rs[2][4]; rs8_table(ssq, rst, u, wr, fr, newpm, rs);
        const rsrc_t ro = mkrsrc(O, MROWS * 2816u * 2u);
        const int vo = ((((u.pm * 44 + 2 * u.pn + (wc >> 1)) * 2 + (wc & 1)) * 256 + wr * 64 + fr) * 32 + 8 * fq) * 2;
#pragma unroll
        for (int ai = 0; ai < 2; ++ai)
#pragma unroll
            for (int m = 0; m < 4; ++m) {
                unsigned w[4];
#pragma unroll
                for (int n = 0; n < 2; ++n) { const f32x4 ag = acc[ai][0][m][n], gu = ag * acc[ai][1][m][n]; const float c1 = rs[ai][m] * -LOG2E, c2 = rs[ai][m] * rs[ai][m]; float o[4];
#pragma unroll
                    for (int j = 0; j < 4; ++j) o[j] = (MODE == 2) ? gu[j] : gu[j] * (c2 * __builtin_amdgcn_rcpf(1.0f + __builtin_amdgcn_exp2f(ag[j] * c1)));
                    w[2 * n] = pk_bf16(o[0], o[1]); w[2 * n + 1] = pk_bf16(o[2], o[3]); }
                if (MODE == 1) asm volatile("" :: "v"(w[0]), "v"(w[1]), "v"(w[2]), "v"(w[3])); else if (MK_NT_MASK & 1) bs128nt(ro, (u32x4){w[0], w[1], w[2], w[3]}, vadd(vo, (ai * HALF + m * 16) * 32 * 2), 0); else bs128(ro, (u32x4){w[0], w[1], w[2], w[3]}, vadd(vo, (ai * HALF + m * 16) * 32 * 2), 0);
            }
    }
};
typedef EpiUpT<0> EpiUp;

template <bool SRC_F32> struct EpiResid {
    static constexpr bool PERM = true, AFTER_DRAIN = false, HAS_MID = false; static constexpr int MID0 = -1, MID1 = -1, NST = 16;
    const void* Xs; bf16_t* XB; float* ssq; PG8_LAS float* P;
    __device__ __forceinline__ void mid(f32x4 (&)[2][2][4][2], const Unit&, int, int, int, int, int) const {}
    __device__ __forceinline__ void operator()(const f32x4 (&acc)[2][2][4][2], const Unit& u, int wr, int wc, int fr, int fq, bool newpm) const {
        const int rl0 = wr * 64 + fr, colw = u.pn * BM + wc * 64 + 8 * fq;
        const bool lo = fr < 8;
        const rsrc_t rs_ = mkrsrc(Xs, MROWS * 1024u * (SRC_F32 ? 4u : 2u)), rb = mkrsrc(XB, MROWS * 1024u * 2u);
        const int rowb = u.pm * BM + wr * 64;
        const int vA = ((rowb + (lo ? fr : fr - 8)) * 1024 + colw + (lo ? 0 : 32)) * 2, vB = ((rowb + (lo ? fr + 8 : fr)) * 1024 + colw + (lo ? 32 : 0)) * 2;
        const int vs = ((rowb + fr) * 1024 + colw) * 4;
#pragma unroll
        for (int ai = 0; ai < 2; ++ai) {
            u32x4 xv[4][2][SRC_F32 ? 2 : 1];
#pragma unroll
            for (int m = 0; m < 4; ++m) { const int ro = (ai * HALF + m * 16) * 1024;
                if (SRC_F32) { const int vr = vadd(vs, ro * 4);
#pragma unroll
                    for (int bj = 0; bj < 2; ++bj) { xv[m][bj][0] = bl128(rs_, vr + bj * 128, 0); xv[m][bj][SRC_F32 ? 1 : 0] = bl128(rs_, vr + bj * 128 + 16, 0); } }
                else { xv[m][0][0] = bl128(rs_, vadd(vA, ro * 2), 0); xv[m][1][0] = bl128(rs_, vadd(vB, ro * 2), 0); } }
#pragma unroll
            for (int m = 0; m < 4; ++m) { float ss = 0.f; const int ro = (ai * HALF + m * 16) * 1024; u32x4 pk[2];
                u32x4 x0, x1; if (!SRC_F32) line_unpack(lo, xv[m][0][0], xv[m][1][0], x0, x1);
#pragma unroll
                for (int bj = 0; bj < 2; ++bj) { f32x4 v0, v1;
                    if (SRC_F32) { v0 = __builtin_bit_cast(f32x4, xv[m][bj][0]); v1 = __builtin_bit_cast(f32x4, xv[m][bj][SRC_F32 ? 1 : 0]); }
                    else { const u32x4 x = bj ? x1 : x0; v0 = (f32x4){bf_lo(x[0]), bf_hi(x[0]), bf_lo(x[1]), bf_hi(x[1])}; v1 = (f32x4){bf_lo(x[2]), bf_hi(x[2]), bf_lo(x[3]), bf_hi(x[3])}; }
                    v0 = v0 + acc[ai][bj][m][0]; v1 = v1 + acc[ai][bj][m][1];
                    pk[bj] = (u32x4){pk_bf16(v0[0], v0[1]), pk_bf16(v0[2], v0[3]), pk_bf16(v1[0], v1[1]), pk_bf16(v1[2], v1[3])};
                    ss += ((v0[0] * v0[0] + v0[1] * v0[1]) + (v0[2] * v0[2] + v0[3] * v0[3])) + ((v1[0] * v1[0] + v1[1] * v1[1]) + (v1[2] * v1[2] + v1[3] * v1[3])); }
                { u32x4 a, b; line_pack(lo, pk[0], pk[1], a, b); if (MK_NT_MASK & 8) { bs128nt(rb, a, vadd(vA, ro * 2), 0); bs128nt(rb, b, vadd(vB, ro * 2), 0); } else { bs128(rb, a, vadd(vA, ro * 2), 0); bs128(rb, b, vadd(vB, ro * 2), 0); } }
                ss += __shfl_xor(ss, 16); ss += __shfl_xor(ss, 32);
                if (fq == 0) P[(rl0 + ai * HALF + m * 16) * 4 + wc] = ss; }
            asm volatile("" ::: "memory");
        }
        asm volatile("s_waitcnt lgkmcnt(0)" ::: "memory"); __builtin_amdgcn_s_barrier(); asm volatile("" ::: "memory");
        if (threadIdx.x < 256) { const f32x4 p = *(const PG8_LAS f32x4*)(P + threadIdx.x * 4); ssq[(size_t)(u.pm * BM + (int)threadIdx.x) * 4 + u.pn] = (p[0] + p[1]) + (p[2] + p[3]); }
    }
};

template <int PM> __device__ __forceinline__ void st128(rsrc_t r, u32x4 v, int voff, int soff) { if (PM >= 1) asm volatile("" :: "v"(v)); else if (MK_NT_MASK & 2) bs128nt(r, v, voff, soff); else bs128(r, v, voff, soff); }
template <int PM> struct EpiInProjT {
    static constexpr bool PERM = true, AFTER_DRAIN = false, HAS_MID = false; static constexpr int MID0 = -1, MID1 = -1, NST = 8;
    bf16_t* PA; bf16_t* PG; const float* ssq; const float* rope; PG8_LAS float* rst;
    __device__ __forceinline__ void mid(f32x4 (&)[2][2][4][2], const Unit&, int, int, int, int, int) const {}
    template <int MODE> __device__ __forceinline__ void blocked(const f32x4 (&acc)[2][2][4][2], const rsrc_t rd, int vo, int s_ai, int s_m, int s_bj) const {
#pragma unroll
        for (int ai = 0; ai < 2; ++ai)
#pragma unroll
            for (int m = 0; m < 4; ++m)
#pragma unroll
                for (int bj = 0; bj < 2; ++bj) { unsigned w[4]; float v[8];
#pragma unroll
                    for (int i = 0; i < 8; ++i) v[i] = acc[ai][bj][m][i >> 2][i & 3];
                    if (MODE == 1) {
                        float t[8];
#pragma unroll
                        for (int i = 0; i < 8; ++i) t[i] = v[i] * -LOG2E;
                        __builtin_amdgcn_sched_barrier(0);
#pragma unroll
                        for (int i = 0; i < 8; ++i) t[i] = __builtin_amdgcn_exp2f(t[i]);
                        __builtin_amdgcn_sched_barrier(0);
#pragma unroll
                        for (int i = 0; i < 8; ++i) t[i] = 1.0f + t[i];
                        __builtin_amdgcn_sched_barrier(0);
#pragma unroll
                        for (int i = 0; i < 8; ++i) t[i] = __builtin_amdgcn_rcpf(t[i]);
                        __builtin_amdgcn_sched_barrier(0);
#pragma unroll
                        for (int i = 0; i < 8; ++i) v[i] = v[i] * t[i];
                    }
#pragma unroll
                    for (int q = 0; q < 4; ++q) w[q] = pk_bf16(v[2 * q], v[2 * q + 1]);
                    st128<PM>(rd, (u32x4){w[0], w[1], w[2], w[3]}, vadd(vo, (ai * s_ai + m * s_m + bj * s_bj) * 2), 0); }
    }
    __device__ __forceinline__ void operator()(f32x4 (&acc)[2][2][4][2], const Unit& u, int wr, int wc, int fr, int fq, bool newpm) const {
        const int row0 = u.pm * BM + wr * 64 + fr, pn = u.pn;
        { float rs[2][4]; rs8_table(ssq, rst, u, wr, fr, newpm, rs);
#pragma unroll
          for (int ai = 0; ai < 2; ++ai)
#pragma unroll
              for (int m = 0; m < 4; ++m)
#pragma unroll
                  for (int bj = 0; bj < 2; ++bj)
#pragma unroll
                      for (int n = 0; n < 2; ++n) {
#if MK_SCALAR_RS
#pragma unroll
                          for (int j = 0; j < 4; ++j) acc[ai][bj][m][n][j] = fmul1(acc[ai][bj][m][n][j], rs[ai][m]);
#else
                          acc[ai][bj][m][n] = acc[ai][bj][m][n] * rs[ai][m];
#endif
                      }
          asm volatile("" : "+v"(acc[0][0][0][0]), "+v"(acc[1][1][3][1])); }
        const rsrc_t ra = mkrsrc(PA, MROWS * 2560u * 2u);
        constexpr int MR = 32768 * 256;
        if (PM == 2 && pn < 10) return; if (PM == 3 && pn != 3 && pn != 4) return; if (PM == 4 && (pn == 3 || pn == 4 || pn >= 10)) return;
        if (pn == 3 || pn == 4) {
            const float sl2g = (pn == 3 ? 1.f : -1.f) * l2gamma(wc);
            const rsrc_t rr = mkrsrc(rope, 16384u * 32u * 8u);
            const int vr = (row0 & 16383) * 256 + fq * 16;
            const int vo = (pn * MR + ((u.pm * 8 + wc) * 2) * 4096 + (wr * 64 + fr) * 32 + 8 * fq) * 2;
#pragma unroll
            for (int ai = 0; ai < 2; ++ai) {
                f32x4 cs[4][4];
#pragma unroll
                for (int m = 0; m < 4; ++m)
#pragma unroll
                    for (int q = 0; q < 4; ++q) cs[m][q] = bl128f(rr, vadd(vr, (ai * HALF + m * 16) * 256) + q * 64, 0);
#pragma unroll
                for (int m = 0; m < 4; ++m) {
                    const int rowi = (row0 + ai * HALF + m * 16) & 127;
                    const float dec = __builtin_amdgcn_exp2f(sl2g * (float)rowi);
                    unsigned w1[4], w2[4];
#pragma unroll
                    for (int q = 0; q < 4; ++q) { const f32x4 c = cs[m][q];
                        const int n = q >> 1, j = (q & 1) * 2;
                        const float xa0 = acc[ai][0][m][n][j], xa1 = acc[ai][0][m][n][j + 1], xb0 = acc[ai][1][m][n][j], xb1 = acc[ai][1][m][n][j + 1];
                        w1[q] = pk_bf16((xa0 * c[0] - xb0 * c[1]) * dec, (xa1 * c[2] - xb1 * c[3]) * dec);
                        w2[q] = pk_bf16((xb0 * c[0] + xa0 * c[1]) * dec, (xb1 * c[2] + xa1 * c[3]) * dec); }
                    { const int vs = vadd(vo, (ai * 32768 + m * 512) * 2); st128<PM>(ra, (u32x4){w1[0], w1[1], w1[2], w1[3]}, vs, 0); st128<PM>(ra, (u32x4){w2[0], w2[1], w2[2], w2[3]}, vadd(vs, 4096 * 2), 0); }
                }
                asm volatile("" ::: "memory");
            }
        } else if (pn >= 10) {
            const rsrc_t rg = mkrsrc(PG, MROWS * 3072u);
            const int vb = (u.pm * 12 + (pn - 10)) * 65536 + ((wr * 4 + wc) * 64 + fq * 16 + fr) * 16;
#pragma unroll
            for (int ai = 0; ai < 2; ++ai)
#pragma unroll
                for (int m = 0; m < 4; ++m) { unsigned w[4];
#pragma unroll
                    for (int bj = 0; bj < 2; ++bj) {
                        float t[8];
#pragma unroll
                        for (int i = 0; i < 8; ++i) t[i] = __builtin_amdgcn_fmed3f(acc[ai][bj][m][i >> 2][i & 3], -200.f, 7.934823f);
                        __builtin_amdgcn_sched_barrier(0);
#pragma unroll
                        for (int i = 0; i < 8; ++i) t[i] = __builtin_amdgcn_exp2f(t[i]);
                        __builtin_amdgcn_sched_barrier(0);
#pragma unroll
                        for (int i = 0; i < 8; ++i) t[i] = __builtin_fmaf(t[i], 1.0f / 255.0f, 1.0f / 255.0f);
                        __builtin_amdgcn_sched_barrier(0);
#pragma unroll
                        for (int i = 0; i < 8; ++i) t[i] = __builtin_amdgcn_rcpf(t[i]);
                        __builtin_amdgcn_sched_barrier(0);
#pragma unroll
                        for (int i = 0; i < 8; ++i) t[i] = __builtin_rintf(t[i]);
                        __builtin_amdgcn_sched_barrier(0);
#pragma unroll
                        for (int n = 0; n < 2; ++n) { unsigned p = 0u;
#pragma unroll
                            for (int j = 0; j < 4; ++j) p = __builtin_amdgcn_cvt_pk_u8_f32(t[4 * n + j], j, p);
                            w[bj * 2 + n] = p; } }
                    st128<PM>(rg, (u32x4){w[0], w[1], w[2], w[3]}, vadd(vb, (ai * 4 + m) * 8192), 0); }
        }
        else if (pn < 3) {
            const int b = u.pm >> 6, t0 = (u.pm & 63) * 256 + wr * 64 + fr;
            blocked<0>(acc, ra, (pn * MR + ((b * 4 + (wc >> 1)) * 2 + (wc & 1)) * 524288 + t0 * 32 + 8 * fq) * 2, 128 * 32, 16 * 32, 4 * 524288);
        } else if (pn == 9) {
            blocked<0>(acc, ra, (9 * MR + row0 * 256 + wc * 32 + 8 * fq) * 2, 128 * 256, 16 * 256, 128);
        } else {
            const int vo = ((pn < 7 ? 5 : 7) * MR + (((u.pm * 8 + ((pn - 5) & 1) * 2) * 4 + wc) * 128 + wr * 64 + fr) * 32 + 8 * fq) * 2;
            if (pn < 7) blocked<0>(acc, ra, vo, 65536, 512, 16384); else blocked<1>(acc, ra, vo, 65536, 512, 16384);
        }
    }
};
typedef EpiInProjT<0> EpiInProj;

struct EpiMerge {
    static constexpr bool PERM = true, AFTER_DRAIN = false, HAS_MID = true; static constexpr int MID0 = 4, MID1 = 12, NST = 16;
    bf16_t* O; const bf16_t* PG;
    __device__ __forceinline__ void mid(f32x4 (&acc)[2][2][4][2], const Unit& u, int t, int wr, int wc, int fr, int fq) const {
        const rsrc_t rg = mkrsrc(PG, MROWS * 3072u);
        const int br = (t == MID0 ? 0 : 1);
        const int va = (u.pm * 12 + br * 4 + u.pn) * 65536 + ((wr * 4 + wc) * 64 + fq * 16 + fr) * 16, vb = va + 4 * 65536;
        u32x4 ga[2][4], gb[2][4];
#pragma unroll
        for (int ai = 0; ai < 2; ++ai)
#pragma unroll
            for (int m = 0; m < 4; ++m) { ga[ai][m] = bl128(rg, vadd(va, (ai * 4 + m) * 8192), 0); gb[ai][m] = bl128(rg, vadd(vb, (ai * 4 + m) * 8192), 0); }
#pragma unroll
        for (int ai = 0; ai < 2; ++ai)
#pragma unroll
            for (int m = 0; m < 4; ++m)
#pragma unroll
                for (int bj = 0; bj < 2; ++bj)
#pragma unroll
                    for (int n = 0; n < 2; ++n) { const unsigned a = ga[ai][m][bj * 2 + n], b = gb[ai][m][bj * 2 + n];
#pragma unroll
                        for (int j = 0; j < 4; ++j) acc[ai][bj][m][n][j] *= (float)((a >> (8 * j)) & 0xffu) * __builtin_amdgcn_rcpf((float)((b >> (8 * j)) & 0xffu)); }
    }
    __device__ __forceinline__ void operator()(const f32x4 (&acc)[2][2][4][2], const Unit& u, int wr, int wc, int fr, int fq, bool newpm) const {
        const bool lo = fr < 8; const int rowb = u.pm * BM + wr * 64, colw = u.pn * BM + wc * 64 + 8 * fq;
        const rsrc_t rg = mkrsrc(PG, MROWS * 3072u), ro = mkrsrc(O, MROWS * 1024u * 2u);
        const int vA = ((rowb + (lo ? fr : fr - 8)) * 1024 + colw + (lo ? 0 : 32)) * 2, vB = ((rowb + (lo ? fr + 8 : fr)) * 1024 + colw + (lo ? 32 : 0)) * 2;
        const int vg = (u.pm * 12 + 2 * 4 + u.pn) * 65536 + ((wr * 4 + wc) * 64 + fq * 16 + fr) * 16;
        u32x4 ga[2][4];
#pragma unroll
        for (int ai = 0; ai < 2; ++ai)
#pragma unroll
            for (int m = 0; m < 4; ++m) ga[ai][m] = bl128(rg, vadd(vg, (ai * 4 + m) * 8192), 0);
#pragma unroll
        for (int ai = 0; ai < 2; ++ai)
#pragma unroll
            for (int m = 0; m < 4; ++m)
                { u32x4 pk[2];
#pragma unroll
                  for (int bj = 0; bj < 2; ++bj) { unsigned w[4];
#pragma unroll
                    for (int q = 0; q < 4; ++q) { const int n = q >> 1, j = (q & 1) * 2; const unsigned a = ga[ai][m][bj * 2 + n];
                        w[q] = pk_bf16(acc[ai][bj][m][n][j] * ((float)((a >> (8 * j)) & 0xffu) * (1.0f / 255.0f)), acc[ai][bj][m][n][j + 1] * ((float)((a >> (8 * j + 8)) & 0xffu) * (1.0f / 255.0f))); }
                    pk[bj] = (u32x4){w[0], w[1], w[2], w[3]}; }
                  u32x4 a, b; line_pack(lo, pk[0], pk[1], a, b); const int ro_ = (ai * HALF + m * 16) * 1024 * 2; if (MK_NT_MASK & 4) { bs128nt(ro, a, vadd(vA, ro_), 0); bs128nt(ro, b, vadd(vB, ro_), 0); } else { bs128(ro, a, vadd(vA, ro_), 0); bs128(ro, b, vadd(vB, ro_), 0); } }
    }
};

struct EpiNull {
    static constexpr bool PERM = false, AFTER_DRAIN = false, HAS_MID = false; static constexpr int MID0 = -1, MID1 = -1, NST = 0;
    __device__ __forceinline__ void mid(f32x4 (&)[2][2][4][2], const Unit&, int, int, int, int, int) const {}
    __device__ __forceinline__ void operator()(const f32x4 (&acc)[2][2][4][2], const Unit&, int, int, int, int, bool) const {
#pragma unroll
        for (int ai = 0; ai < 2; ++ai)
#pragma unroll
            for (int bj = 0; bj < 2; ++bj)
#pragma unroll
                for (int m = 0; m < 4; ++m)
#pragma unroll
                    for (int n = 0; n < 2; ++n) asm volatile("" :: "v"(acc[ai][bj][m][n]));
    }
};

template <class Epi, class Sched, bool ALIGN_EPI = false, bool SP2 = false, bool ABLK = false>
__device__ __forceinline__ void gemm_phase(PG8_LAS unsigned char* lds, const Gemm g, const Sched& S, const Epi& E) {
    int tid_op = threadIdx.x; asm volatile("" : "+v"(tid_op));
    const int tid = tid_op, wid = __builtin_amdgcn_readfirstlane(tid >> 6), lane = tid & 63, wr = wid >> 2, wc = wid & 3, fr = lane & 15, fq = lane >> 4;
    const int K = g.K, nt = K / BK;
    unsigned voffA[2], voffB[2];
#pragma unroll
    for (int i = 0; i < 2; ++i) { int R, C; stage_rc(tid * 16 + i * 8192, R, C); const int Rb = Epi::PERM ? ((R & ~31) + perm32(R & 31)) : R;
        voffA[i] = ABLK ? (unsigned)((R * 32 + (C & 31)) * 2 + (C >> 5) * 16384) : (unsigned)(R * K + C) * 2u; voffB[i] = (unsigned)((Rb * 32 + (C & 31)) * 2 + (C >> 5) * 16384); }
    const size_t kstep = ABLK ? (size_t)32768 : (size_t)(BK * 2);
    const size_t hstep = ABLK ? (size_t)8192 : (size_t)HALF * K * 2;
    const size_t tstep = ABLK ? (size_t)nt * 32768 : 2 * hstep;
    const size_t kstepB = 32768, hstepB = 8192, tstepB = (size_t)nt * 32768;
    const unsigned ldsw = (unsigned)wid * 1024u;
    const int aoff = lds_byte(wr * 64 + fr, fq * 8), boff = lds_byte(wc * 32 + fr, fq * 8);
#define PG8_SA(b, h) (((b) * 2 + (h)) * HTB)
#define PG8_SB(b, h) ((4 + (b) * 2 + (h)) * HTB)
#define PG8_STAGE(bufoff, gbase, voff) do { _Pragma("unroll") for (int _i = 0; _i < 2; ++_i) \
        __builtin_amdgcn_global_load_lds((const unsigned*)((const char*)(gbase) + (voff)[_i]), (PG8_LAS unsigned*)(lds + (bufoff) + ldsw + _i * 8192), 16, 0, 0); } while (0)
#define PG8_LDA(dst, b, h) do { _Pragma("unroll") for (int m = 0; m < 4; ++m) _Pragma("unroll") for (int k = 0; k < 2; ++k) dst[m][k] = *(const PG8_LAS bf16x8*)(lds + PG8_SA(b, h) + aoff + m * 2048 + k * 1024); } while (0)
#define PG8_LDB(dst, b, h) do { _Pragma("unroll") for (int n = 0; n < 2; ++n) _Pragma("unroll") for (int k = 0; k < 2; ++k) dst[n][k] = *(const PG8_LAS bf16x8*)(lds + PG8_SB(b, h) + boff + n * 2048 + k * 1024); } while (0)
#define PG8_MMA(ai, bj, At, Bt) do { __builtin_amdgcn_s_setprio(1); _Pragma("unroll") for (int m = 0; m < 4; ++m) _Pragma("unroll") for (int n = 0; n < 2; ++n) _Pragma("unroll") for (int k = 0; k < 2; ++k) \
        acc[ai][bj][m][n] = __builtin_amdgcn_mfma_f32_16x16x32_bf16(Bt[n][k], At[m][k], acc[ai][bj][m][n], 0, 0, 0); __builtin_amdgcn_s_setprio(0); } while (0)
#define PG8_WAIT_V(n) asm volatile("s_waitcnt vmcnt(" #n ")" ::: "memory")
#define PG8_WAIT_L(n) asm volatile("s_waitcnt lgkmcnt(" #n ")" ::: "memory")
#define PG8_WAIT_V8R(relax) do { if (relax) asm volatile("s_waitcnt vmcnt(%0)" :: "n"(8 + Epi::NST) : "memory"); else PG8_WAIT_V(8); } while (0)
#define PG8_BAR __builtin_amdgcn_s_barrier()
#define PG8_SCHED __builtin_amdgcn_sched_barrier(0)
    Unit cur, nxt; int ui = 0; int prev_pm = -1;
    if (!S.next(0, cur)) return;
    f32x4 acc[2][2][4][2];
#pragma unroll
    for (int a = 0; a < 2; ++a)
#pragma unroll
        for (int b = 0; b < 2; ++b)
#pragma unroll
            for (int m = 0; m < 4; ++m)
#pragma unroll
                for (int n = 0; n < 2; ++n) acc[a][b][m][n] = (f32x4){0.f, 0.f, 0.f, 0.f};
    bf16x8 At[4][2], B0[2][2], B1[2][2];
    const char* cA = (const char*)g.A + (size_t)cur.pm * tstep; const char* cB = (const char*)g.Bt + (size_t)cur.pn * tstepB;
    S.a_ready(cur);
    if constexpr (SP2) {
        PG8_STAGE(PG8_SB(0, 0), cB, voffB); PG8_STAGE(PG8_SB(0, 1), cB + hstepB, voffB); PG8_STAGE(PG8_SA(0, 0), cA, voffA); PG8_STAGE(PG8_SA(0, 1), cA + hstep, voffA);
        if (wr == 1) PG8_BAR;
        PG8_WAIT_V(2); PG8_BAR;
        PG8_STAGE(PG8_SB(1, 0), cB + kstepB, voffB); PG8_STAGE(PG8_SA(1, 0), cA + kstep, voffA); PG8_STAGE(PG8_SB(1, 1), cB + hstepB + kstepB, voffB);
        PG8_WAIT_V(6); PG8_BAR;
    } else {
        PG8_STAGE(PG8_SB(0, 0), cB, voffB); PG8_STAGE(PG8_SA(0, 0), cA, voffA); PG8_STAGE(PG8_SB(0, 1), cB + hstepB, voffB); PG8_STAGE(PG8_SA(0, 1), cA + hstep, voffA);
        if (wr == 1) PG8_BAR;
        PG8_WAIT_V(4); PG8_BAR;
        PG8_STAGE(PG8_SB(1, 0), cB + kstepB, voffB); PG8_STAGE(PG8_SA(1, 0), cA + kstep, voffA); PG8_STAGE(PG8_SB(1, 1), cB + hstepB + kstepB, voffB);
        PG8_WAIT_V(6); PG8_BAR;
    }
    for (;;) {
        const bool has_next = S.next(ui + 1, nxt);
        const char* nA = has_next ? (const char*)g.A + (size_t)nxt.pm * tstep : cA; const char* nB = has_next ? (const char*)g.Bt + (size_t)nxt.pn * tstepB : cB;
        for (int t = 0; t < nt; t += 2) {
            const bool last = (t == nt - 2); int relax_ = __builtin_amdgcn_readfirstlane((int)((t == 0) & (ui > 0) & (Epi::NST > 0))); asm volatile("" : "+s"(relax_)); const bool relax = relax_ != 0;
            const char* a1 = cA + (size_t)(t + 1) * kstep;
            const char* a2 = last ? nA : cA + (size_t)(t + 2) * kstep; const char* b2 = last ? nB : cB + (size_t)(t + 2) * kstepB;
            const char* a3 = a2 + kstep; const char* b3 = b2 + kstepB;
            if (last && has_next) S.a_ready(nxt);
            if constexpr (Epi::HAS_MID) { if (t == Epi::MID0 || t == Epi::MID1) E.mid(acc, cur, t, wr, wc, fr, fq); }
            if constexpr (SP2) {
            PG8_LDB(B0, 0, 0); PG8_LDB(B1, 0, 1); PG8_SCHED; PG8_LDA(At, 0, 0); PG8_STAGE(PG8_SA(1, 1), a1 + hstep, voffA);
            PG8_WAIT_V8R(relax); PG8_WAIT_L(0); PG8_BAR; PG8_MMA(0, 0, At, B0); PG8_MMA(0, 1, At, B1); PG8_BAR; PG8_SCHED;
            PG8_LDA(At, 0, 1); PG8_STAGE(PG8_SB(0, 0), b2, voffB); PG8_STAGE(PG8_SB(0, 1), b2 + hstepB, voffB); PG8_STAGE(PG8_SA(0, 0), a2, voffA);
            PG8_WAIT_V8R(relax); PG8_WAIT_L(0); PG8_BAR; PG8_MMA(1, 0, At, B0); PG8_MMA(1, 1, At, B1); PG8_BAR; PG8_SCHED;
            PG8_LDB(B0, 1, 0); PG8_LDB(B1, 1, 1); PG8_SCHED; PG8_LDA(At, 1, 0); PG8_STAGE(PG8_SA(0, 1), a2 + hstep, voffA);
            PG8_WAIT_V(8); PG8_WAIT_L(0); PG8_BAR; PG8_MMA(0, 0, At, B0); PG8_MMA(0, 1, At, B1); PG8_BAR; PG8_SCHED;
            PG8_LDA(At, 1, 1); PG8_STAGE(PG8_SB(1, 0), b3, voffB); PG8_STAGE(PG8_SB(1, 1), b3 + hstepB, voffB); PG8_STAGE(PG8_SA(1, 0), a3, voffA);
            PG8_WAIT_V(8); PG8_WAIT_L(0); PG8_BAR; PG8_MMA(1, 0, At, B0); PG8_MMA(1, 1, At, B1); PG8_BAR; PG8_SCHED;
            } else {
            PG8_LDB(B0, 0, 0); PG8_SCHED; PG8_LDA(At, 0, 0); PG8_STAGE(PG8_SA(1, 1), a1 + hstep, voffA);
            PG8_WAIT_L(8); PG8_BAR; PG8_WAIT_L(0); PG8_MMA(0, 0, At, B0); PG8_BAR; PG8_SCHED;
            PG8_LDB(B1, 0, 1); PG8_STAGE(PG8_SB(0, 0), b2, voffB);
            PG8_BAR; PG8_WAIT_L(0); PG8_MMA(0, 1, At, B1); PG8_BAR;
            PG8_LDA(At, 0, 1); PG8_STAGE(PG8_SA(0, 0), a2, voffA);
            PG8_BAR; PG8_WAIT_L(0); PG8_MMA(1, 0, At, B0); PG8_BAR; PG8_SCHED;
            PG8_STAGE(PG8_SB(0, 1), b2 + hstepB, voffB);
            PG8_WAIT_V(6); PG8_BAR; PG8_MMA(1, 1, At, B1); PG8_BAR;
            PG8_LDB(B0, 1, 0); PG8_SCHED; PG8_LDA(At, 1, 0); PG8_STAGE(PG8_SA(0, 1), a2 + hstep, voffA);
            PG8_WAIT_L(8); PG8_BAR; PG8_WAIT_L(0); PG8_MMA(0, 0, At, B0); PG8_BAR; PG8_SCHED;
            PG8_LDB(B1, 1, 1); PG8_STAGE(PG8_SB(1, 0), b3, voffB);
            PG8_BAR; PG8_WAIT_L(0); PG8_MMA(0, 1, At, B1); PG8_BAR;
            PG8_LDA(At, 1, 1); PG8_STAGE(PG8_SA(1, 0), a3, voffA);
            PG8_BAR; PG8_WAIT_L(0); PG8_MMA(1, 0, At, B0); PG8_BAR; PG8_SCHED;
            PG8_STAGE(PG8_SB(1, 1), b3 + hstepB, voffB);
            PG8_WAIT_V(6); PG8_BAR; PG8_MMA(1, 1, At, B1); PG8_BAR;
            }
        }
        if constexpr (ALIGN_EPI) { if (wr == 0) PG8_BAR; }
        if constexpr (!Epi::AFTER_DRAIN) { E(acc, cur, wr, wc, fr, fq, cur.pm != prev_pm); prev_pm = cur.pm; S.done(cur); }
        if (!has_next) break;
#pragma unroll
        for (int a = 0; a < 2; ++a)
#pragma unroll
            for (int b = 0; b < 2; ++b)
#pragma unroll
                for (int m = 0; m < 4; ++m)
#pragma unroll
                    for (int n = 0; n < 2; ++n) acc[a][b][m][n] = (f32x4){0.f, 0.f, 0.f, 0.f};
        cur = nxt; cA = nA; cB = nB; ++ui;
        if constexpr (ALIGN_EPI) { if (wr == 1) PG8_BAR; }
    }
    PG8_WAIT_V(0);
    if constexpr (!ALIGN_EPI) { if (wr == 0) PG8_BAR; }
    PG8_BAR;
    if constexpr (Epi::AFTER_DRAIN) { E.fused(acc, cur, wr, wc, fr, fq, lds, wid, lane); S.done(cur); }
#undef PG8_SA
#undef PG8_SB
#undef PG8_STAGE
#undef PG8_LDA
#undef PG8_LDB
#undef PG8_MMA
#undef PG8_WAIT_V
#undef PG8_WAIT_L
#undef PG8_WAIT_V8R
#undef PG8_BAR
#undef PG8_SCHED
}
}


constexpr int NWAVES = 8;
constexpr int BATCH = 2, SEQ = 16384, DM = 1024, DFF = 2816, DIN = 5632, DEPTH = 2;
constexpr int M = BATCH * SEQ;
constexpr int PA_LD = 2560, PG_LD = 3072;
constexpr size_t MR = (size_t)32768 * 256;
constexpr size_t PA_QSB = 0, PA_KSB = MR, PA_VSB = 2 * MR, PA_QR = 3 * MR, PA_KR = 4 * MR, PA_VR = 5 * MR, PA_GR = 7 * MR, PA_UP = 9 * MR;
constexpr int Y_SB = 0, Y_RET = 256, Y_POOL = 768;
constexpr int NCHUNK = SEQ / 128;
constexpr size_t MiB = 1u << 20;
constexpr size_t WS_CTL = 0, CTL_ZERO_BYTES = 64 * 1024;
constexpr size_t WS_SSQ = 1 * MiB;
constexpr size_t WS_ROPE = 2 * MiB;
constexpr size_t WS_W = 6 * MiB;
constexpr size_t W_13A = 0, W_2A = 11534336, W_IN = 17301504, W_B = 28835840, W_OUT = 30932992, W_13B = 33030144, W_2B = 44564480;
constexpr size_t WS_STATE = WS_W;
constexpr size_t WS_XB = 54 * MiB;
constexpr size_t WS_PA = 118 * MiB;
constexpr size_t WS_MRG = WS_PA;
constexpr size_t WS_ACT = WS_PA;
constexpr size_t WS_PG = 278 * MiB;
constexpr size_t WS_KV = 470 * MiB;
constexpr size_t WS_END = 502 * MiB;
static_assert(W_2B + 5767168 <= 48 * MiB && WS_W + 48 * MiB <= WS_XB && WS_XB + (size_t)M * 1024 * 2 <= WS_PA && WS_PA + (size_t)M * 2560 * 2 <= WS_PG && WS_PG + (size_t)M * 3072 * 2 <= WS_KV && WS_ACT + (size_t)M * 2816 * 2 <= WS_KV && WS_KV + 32 * MiB <= WS_END, "ws map");
constexpr int RING_BYTES = 131072;
constexpr int PSTAT_OFF = RING_BYTES;
constexpr int MISC_OFF = PSTAT_OFF + 4096;
constexpr int LDS_BYTES = 147456;

#define GAS __attribute__((address_space(1)))
#define LAS __attribute__((address_space(3)))
typedef unsigned short bf16;
typedef float f32x4 __attribute__((ext_vector_type(4)));
typedef float f32x16 __attribute__((ext_vector_type(16)));
typedef short bf16x8 __attribute__((ext_vector_type(8)));
typedef short s16x4 __attribute__((ext_vector_type(4)));
typedef unsigned u32x4 __attribute__((ext_vector_type(4)));
typedef unsigned u32x2 __attribute__((ext_vector_type(2)));
using pg8::pk_bf16; using pg8::bf_lo; using pg8::bf_hi; using pg8::l2gamma;

#define XB_TMO      128
#define XB_XCNT(j)  (256  + 64 * (j))
#define XB_XSUB(j)  (1280 + 64 * (j))
#define XB_XGEN(j)  (2304 + 64 * (j))
#define XB_TOP      3328
#define XB_TOPGEN   3392
#define XCD_BAR_WORDS 3456
#define XB_SPIN_CAP (1u << 18)

__device__ __forceinline__ unsigned xb_ld(unsigned* p)              { return __hip_atomic_load(p, __ATOMIC_RELAXED, __HIP_MEMORY_SCOPE_AGENT); }
__device__ __forceinline__ unsigned xb_add(unsigned* p, unsigned v) { return __hip_atomic_fetch_add(p, v, __ATOMIC_RELAXED, __HIP_MEMORY_SCOPE_AGENT); }
__device__ __forceinline__ unsigned xb_xcc_id() { return (unsigned)__builtin_amdgcn_s_getreg((3 << 11) | 20) & 0xFu; }
#define XB_SPIN(cond, bar) do { unsigned _sp = 0; while (cond) { __builtin_amdgcn_s_sleep(1); \
    if ((++_sp & 255u) == 0u) { if (xb_ld(&(bar)[XB_TMO])) break; if (_sp > XB_SPIN_CAP) { atomicAdd(&(bar)[XB_TMO], 1u); break; } } } } while (0)

struct XcdBarrier {
    unsigned* bar; unsigned x;
    volatile LAS unsigned* st;
};

__device__ __forceinline__ XcdBarrier xcd_barrier_post(unsigned* bar, volatile LAS unsigned* st) {
    XcdBarrier b; b.bar = bar; b.x = xb_xcc_id(); b.st = st;
    if (threadIdx.x == 0) (void)xb_add(&bar[XB_XCNT(b.x)], 1u);
    return b;
}
__device__ __forceinline__ void xcd_barrier_complete(unsigned* bar, unsigned x, unsigned& nloc, unsigned& nx) {
    const unsigned G = gridDim.x * gridDim.y * gridDim.z;
    unsigned sum, cnt, mine, sp = 0u;
    for (;;) {
        sum = 0u; cnt = 0u; mine = 0u;
#pragma unroll
        for (unsigned j = 0; j < 16; ++j) { const unsigned c = xb_ld(&bar[XB_XCNT(j)]); sum += c; cnt += (c > 0u) ? 1u : 0u; mine = (j == x) ? c : mine; }
        if (sum == G) break;
        __builtin_amdgcn_s_sleep(1);
        if ((++sp & 255u) == 0u) { if (xb_ld(&bar[XB_TMO])) break; if (sp > XB_SPIN_CAP) { atomicAdd(&bar[XB_TMO], 1u); break; } }
    }
    nloc = mine > 0u ? mine : 1u; nx = cnt > 0u ? cnt : 1u;
}

__device__ __forceinline__ void xcd_barrier(const XcdBarrier& b) {
    asm volatile("s_waitcnt vmcnt(0)" ::: "memory");
    __syncthreads();
    if (threadIdx.x == 0) {
        unsigned* bar = b.bar;
        __builtin_amdgcn_s_waitcnt(0);
        unsigned nloc = b.st[0], nx = b.st[1];
        if (nloc == 0u) { xcd_barrier_complete(bar, b.x, nloc, nx); b.st[0] = nloc; b.st[1] = nx; }
        const unsigned old = xb_add(&bar[XB_XSUB(b.x)], 1u);
        const unsigned gen = old / nloc;
        if (old + 1u == (gen + 1u) * nloc) {
            __builtin_amdgcn_fence(__ATOMIC_RELEASE, "agent");
            asm volatile("s_waitcnt vmcnt(0)" ::: "memory");
            const unsigned og = xb_add(&bar[XB_TOP], 1u);
            const unsigned tg = og / nx;
            if (og + 1u == (tg + 1u) * nx) xb_add(&bar[XB_TOPGEN], 1u);
            else XB_SPIN(xb_ld(&bar[XB_TOPGEN]) == tg, bar);
            __builtin_amdgcn_fence(__ATOMIC_ACQUIRE, "agent");
            xb_add(&bar[XB_XGEN(b.x)], 1u);
            asm volatile("s_waitcnt vmcnt(0)" ::: "memory");
        } else {
            XB_SPIN(xb_ld(&bar[XB_XGEN(b.x)]) == gen, bar);
            __builtin_amdgcn_fence(__ATOMIC_ACQUIRE, "agent");
            asm volatile("s_waitcnt vmcnt(0)" ::: "memory");
        }
    }
    __syncthreads();
}


__device__ __forceinline__ float wave_sum(float v) {
#pragma unroll
    for (int o = 1; o < 64; o <<= 1) v += __shfl_xor(v, o);
    return v;
}
__device__ __forceinline__ float xhalf(float v) { return __shfl_xor(v, 32); }
__device__ __forceinline__ s16x4 vtr(LAS const unsigned char* p) { return __builtin_bit_cast(s16x4, __builtin_amdgcn_ds_read_tr16_b64_v4i16((LAS s16x4*)p)); }
__device__ __forceinline__ bf16x8 trfrag(LAS const unsigned char* img, int ks, int laneoff) {
    const s16x4 lo = vtr(img + ks * 1024 + laneoff), hi = vtr(img + ks * 1024 + 512 + laneoff);
    return (bf16x8){lo[0], lo[1], lo[2], lo[3], hi[0], hi[1], hi[2], hi[3]};
}
__device__ __forceinline__ bf16x8 accfrag(const f32x16& p, int s) {
    const u32x4 w = {pk_bf16(p[8 * s + 0], p[8 * s + 1]), pk_bf16(p[8 * s + 2], p[8 * s + 3]), pk_bf16(p[8 * s + 4], p[8 * s + 5]), pk_bf16(p[8 * s + 6], p[8 * s + 7])};
    return __builtin_bit_cast(bf16x8, w);
}
__device__ __forceinline__ void stage128x32(LAS unsigned char* img, const bf16* src, int ld, int lane) {
    u32x4 v[8];
#pragma unroll
    for (int i = 0; i < 8; ++i) { const int c = lane + 64 * i, key = c >> 2, ch = c & 3; v[i] = *(const u32x4*)(src + (size_t)key * ld + ch * 8); }
#pragma unroll
    for (int i = 0; i < 8; ++i) { const int c = lane + 64 * i, key = c >> 2, ch = c & 3; *(LAS u32x4*)(img + (key >> 4) * 1024 + (key & 15) * 64 + ch * 16) = v[i]; }
}

__device__ __forceinline__ void sb_exp(const f32x16& z, float (&e)[16]) {
#pragma unroll
    for (int r = 0; r < 16; ++r) e[r] = __builtin_amdgcn_exp2f(__builtin_amdgcn_fmed3f(z[r], -200.f, 30.f));
}
__device__ __forceinline__ void sb_mask(float (&e)[16], int lim2) {
#pragma unroll
    for (int g = 0; g < 4; ++g)
#pragma unroll
        for (int i = 0; i < 4; ++i) e[4 * g + i] = (i + 8 * g < lim2) ? e[4 * g + i] : 0.f;
}
__device__ __forceinline__ void sb_weights(const float (&e)[16], f32x16& w, float& run, bool lo_half) {
    float P[4][3], cs[4], clo[4], chi[4];
#pragma unroll
    for (int g = 0; g < 4; ++g) {
        P[g][0] = 1.0f + e[4 * g]; P[g][1] = P[g][0] * (1.0f + e[4 * g + 1]); P[g][2] = P[g][1] * (1.0f + e[4 * g + 2]);
        cs[g] = __builtin_amdgcn_rcpf(P[g][2] * (1.0f + e[4 * g + 3]));
        clo[g] = cs[g]; chi[g] = cs[g];
        asm("s_nop 1\n\tv_permlane32_swap_b32 %0, %1" : "+v"(clo[g]), "+v"(chi[g])); }
    float T[4]; T[3] = run; T[2] = T[3] * (clo[3] * chi[3]); T[1] = T[2] * (clo[2] * chi[2]); T[0] = T[1] * (clo[1] * chi[1]); run = T[0] * (clo[0] * chi[0]);
#pragma unroll
    for (int g = 0; g < 4; ++g) { const float R = cs[g] * (T[g] * (lo_half ? chi[g] : 1.0f));
        w[4 * g] = e[4 * g] * R; w[4 * g + 1] = e[4 * g + 1] * (P[g][0] * R); w[4 * g + 2] = e[4 * g + 2] * (P[g][1] * R); w[4 * g + 3] = e[4 * g + 3] * (P[g][2] * R); }
}
__device__ __forceinline__ void sb_item(const bf16* PA_, bf16* Y_, LAS unsigned char* wl, int b, int h, int qb, int lane, int force = 0) {
    const GAS bf16* PA = (const GAS bf16*)PA_; GAS bf16* Y = (GAS bf16*)Y_;
    const int r = lane & 31, hi = lane >> 5; const size_t seq0 = (size_t)b * SEQ; const int R0 = qb * 32;
    const int laneoff = (4 * hi + ((lane & 15) >> 2)) * 64 + ((lane >> 4) & 1) * 32 + (lane & 3) * 8;
    bf16x8 qf[4];
    const size_t hb = (size_t)((b * 4 + h) * 2) * (SEQ * 32);
    { const GAS bf16* qp = PA + PA_QSB + hb + (size_t)(R0 + r) * 32 + hi * 8;
#pragma unroll
      for (int kk = 0; kk < 4; ++kk) qf[kk] = *(const GAS bf16x8*)(qp + (size_t)(kk >> 1) * (SEQ * 32) + (kk & 1) * 16); }
    f32x16 o0 = {}, o1 = {}; float carry = 1.0f;
    bf16x8 ka[4], kb[4]; u32x4 vst[8];
    const int J0 = R0 >> 6;
    const GAS bf16* kp = PA + PA_KSB + hb + (size_t)(64 * J0 + r) * 32 + hi * 8;
    const GAS bf16* vp = PA + PA_VSB + hb + (size_t)(64 * J0) * 32 + lane * 8;
#pragma unroll
    for (int kk = 0; kk < 4; ++kk) { ka[kk] = *(const GAS bf16x8*)(kp + (size_t)(kk >> 1) * (SEQ * 32) + (kk & 1) * 16); kb[kk] = *(const GAS bf16x8*)(kp + (size_t)(kk >> 1) * (SEQ * 32) + 32 * 32 + (kk & 1) * 16); }
#pragma unroll
    for (int i = 0; i < 8; ++i) vst[i] = *(const GAS u32x4*)(vp + (size_t)(i >> 2) * (SEQ * 32) + (i & 3) * 512);
    for (int J = J0; J >= 0; --J) {
        f32x16 p0 = {}, p1 = {};
#pragma unroll
        for (int kk = 0; kk < 4; ++kk) { p0 = __builtin_amdgcn_mfma_f32_32x32x16_bf16(ka[kk], qf[kk], p0, 0, 0, 0); p1 = __builtin_amdgcn_mfma_f32_32x32x16_bf16(kb[kk], qf[kk], p1, 0, 0, 0); }
#pragma unroll
        for (int i = 0; i < 8; ++i) *(LAS u32x4*)(wl + i * 1024 + lane * 16) = vst[i];
        if (J > 0) {
            kp -= 64 * 32; vp -= 64 * 32;
#pragma unroll
            for (int kk = 0; kk < 4; ++kk) { ka[kk] = *(const GAS bf16x8*)(kp + (size_t)(kk >> 1) * (SEQ * 32) + (kk & 1) * 16); kb[kk] = *(const GAS bf16x8*)(kp + (size_t)(kk >> 1) * (SEQ * 32) + 32 * 32 + (kk & 1) * 16); }
#pragma unroll
            for (int i = 0; i < 8; ++i) vst[i] = *(const GAS u32x4*)(vp + (size_t)(i >> 2) * (SEQ * 32) + (i & 3) * 512);
        }
        const int lim = R0 + r - 64 * J - 4 * hi;
        bf16x8 vf[8];
#pragma unroll
        for (int i = 0; i < 4; ++i) { vf[i] = trfrag(wl, i, laneoff); vf[4 + i] = trfrag(wl + 4096, i, laneoff); }
        __builtin_amdgcn_sched_barrier(0);
        f32x16 w0, w1; float run = carry; float e0[16], e1[16];
        sb_exp(p1, e1); sb_exp(p0, e0);
        if (J == J0) { sb_mask(e1, lim - 32); sb_mask(e0, lim); }
        sb_weights(e1, w1, run, hi == 0); sb_weights(e0, w0, run, hi == 0);
        carry = run;
        const bf16x8 pf0 = accfrag(w0, 0), pf1 = accfrag(w0, 1), pf2 = accfrag(w1, 0), pf3 = accfrag(w1, 1);
        __builtin_amdgcn_sched_barrier(0);
        o0 = __builtin_amdgcn_mfma_f32_32x32x16_bf16(vf[0], pf0, o0, 0, 0, 0); o1 = __builtin_amdgcn_mfma_f32_32x32x16_bf16(vf[4], pf0, o1, 0, 0, 0);
        o0 = __builtin_amdgcn_mfma_f32_32x32x16_bf16(vf[1], pf1, o0, 0, 0, 0); o1 = __builtin_amdgcn_mfma_f32_32x32x16_bf16(vf[5], pf1, o1, 0, 0, 0);
        o0 = __builtin_amdgcn_mfma_f32_32x32x16_bf16(vf[2], pf2, o0, 0, 0, 0); o1 = __builtin_amdgcn_mfma_f32_32x32x16_bf16(vf[6], pf2, o1, 0, 0, 0);
        o0 = __builtin_amdgcn_mfma_f32_32x32x16_bf16(vf[3], pf3, o0, 0, 0, 0); o1 = __builtin_amdgcn_mfma_f32_32x32x16_bf16(vf[7], pf3, o1, 0, 0, 0);
        asm volatile("" ::: "memory");
        if (force ? (J0 - J + 1 >= force) : (int)__all(carry < 1e-36f)) break;
    }
    { LAS unsigned char* st = wl + 8192 + r * 144 + hi * 8;
#pragma unroll
      for (int g = 0; g < 4; ++g) {
          *(LAS u32x2*)(st + 16 * g) = (u32x2){pk_bf16(o0[4 * g], o0[4 * g + 1]), pk_bf16(o0[4 * g + 2], o0[4 * g + 3])};
          *(LAS u32x2*)(st + 64 + 16 * g) = (u32x2){pk_bf16(o1[4 * g], o1[4 * g + 1]), pk_bf16(o1[4 * g + 2], o1[4 * g + 3])}; }
      asm volatile("" ::: "memory");
      GAS bf16* yb = Y + (seq0 + R0) * 1024 + Y_SB + h * 64 + (lane & 7) * 8;
#pragma unroll
      for (int i = 0; i < 4; ++i) { const int row = 8 * i + (lane >> 3);
          const u32x4 v = *(const LAS u32x4*)(wl + 8192 + row * 144 + (lane & 7) * 16);
          *(GAS u32x4*)(yb + (size_t)row * 1024) = v; }
      asm volatile("" ::: "memory"); }
}

__device__ __forceinline__ void kv_load(const GAS bf16* PA, int it, int lane, u32x4 (&va)[8], u32x4 (&ka)[8]) {
    const int b = it >> 12, n = (it >> 5) & 127, h = (it >> 3) & 3, eb = (it >> 1) & 3, db = it & 1;
    const size_t ch = (size_t)((b * NCHUNK + n) * 4 + h);
    const GAS bf16* vs = PA + PA_VR + (ch * 4 + eb) * 4096 + lane * 8; const GAS bf16* ks = PA + PA_KR + (ch * 2 + db) * 4096 + lane * 8;
#pragma unroll
    for (int i = 0; i < 8; ++i) { va[i] = *(const GAS u32x4*)(vs + i * 512); ka[i] = *(const GAS u32x4*)(ks + i * 512); }
}
__device__ __forceinline__ void kv_items(const bf16* PA_, float* KV_, LAS unsigned char* wl, int gw, int NGW, int lane) {
    const GAS bf16* PA = (const GAS bf16*)PA_; GAS float* KV = (GAS float*)KV_;
    constexpr int NIT = BATCH * NCHUNK * 4 * 8;
    const int r = lane & 31, hi = lane >> 5;
    const int laneoff = (4 * hi + ((lane & 15) >> 2)) * 64 + ((lane >> 4) & 1) * 32 + (lane & 3) * 8;
    const int vdst = (lane >> 2) * 64 + (lane & 3) * 16;
    int it = gw; if (it >= NIT) return;
    u32x4 va[8], ka[8]; kv_load(PA, it, lane, va, ka);
    for (;;) {
#pragma unroll
        for (int i = 0; i < 8; ++i) { *(LAS u32x4*)(wl + i * 1024 + lane * 16) = va[i]; *(LAS u32x4*)(wl + 8192 + i * 1024 + lane * 16) = ka[i]; }
        const int nit = it + NGW; const bool more = nit < NIT;
        if (more) kv_load(PA, nit, lane, va, ka);
        asm volatile("" ::: "memory");
        f32x16 acc = {};
#pragma unroll
        for (int ks = 0; ks < 8; ++ks) acc = __builtin_amdgcn_mfma_f32_32x32x16_bf16(trfrag(wl, ks, laneoff), trfrag(wl + 8192, ks, laneoff), acc, 0, 0, 0);
        asm volatile("" ::: "memory");
        const int b = it >> 12, n = (it >> 5) & 127, h = (it >> 3) & 3, eb = (it >> 1) & 3, db = it & 1;
        const float sc = __builtin_amdgcn_exp2f(127.0f * l2gamma(h));
        GAS float* op = KV + (((size_t)(b * NCHUNK + n) * 4 + h) * 128 + eb * 32 + 4 * hi) * 64 + db * 32 + r;
#pragma unroll
        for (int g = 0; g < 4; ++g)
#pragma unroll
            for (int i = 0; i < 4; ++i) op[(size_t)(8 * g + i) * 64] = acc[4 * g + i] * sc;
        if (!more) break;
        it = nit;
    }
}
__device__ __forceinline__ void kv_group(const bf16* PA_, float* KV_, LAS unsigned char* lds, int vcu, int G, int wave, int lane) {
    constexpr int NCH = BATCH * NCHUNK * 4;
    GAS bf16* KV = (GAS bf16*)KV_;
    const int r = lane & 31, hi = lane >> 5, eb = wave >> 1, db = wave & 1;
    const int laneoff = (4 * hi + ((lane & 15) >> 2)) * 64 + ((lane >> 4) & 1) * 32 + (lane & 3) * 8;
    auto issue = [&](int chh, int buf) {
        const bf16* vb = PA_ + PA_VR + (size_t)chh * 16384 + lane * 8; const bf16* kb = PA_ + PA_KR + (size_t)chh * 8192 + lane * 8;
#pragma unroll
        for (int i = 0; i < 6; ++i) { const int j = wave * 6 + i;
            if (j < 32) __builtin_amdgcn_global_load_lds((const unsigned*)(vb + j * 512), (LAS unsigned*)(lds + buf * 49152 + j * 1024), 16, 0, 0);
            else __builtin_amdgcn_global_load_lds((const unsigned*)(kb + (j - 32) * 512), (LAS unsigned*)(lds + buf * 49152 + j * 1024), 16, 0, 0); } };
    __syncthreads();
    if (vcu < NCH) issue(vcu, 0);
    int k = 0;
    for (int chh = vcu; chh < NCH; chh += G, ++k) {
        if (k == 0) asm volatile("s_waitcnt vmcnt(0)" ::: "memory"); else asm volatile("s_waitcnt vmcnt(16)" ::: "memory");
        __syncthreads(); asm volatile("" ::: "memory");
        if (chh + G < NCH) issue(chh + G, (k + 1) & 1);
        const LAS unsigned char* vi = lds + (k & 1) * 49152 + eb * 8192; const LAS unsigned char* ki = lds + (k & 1) * 49152 + 32768 + db * 8192;
        f32x16 acc = {};
#pragma unroll
        for (int ks = 0; ks < 8; ++ks) acc = __builtin_amdgcn_mfma_f32_32x32x16_bf16(trfrag(vi, ks, laneoff), trfrag(ki, ks, laneoff), acc, 0, 0, 0);
        int hq = __builtin_amdgcn_readfirstlane(chh & 3); asm volatile("" : "+s"(hq));
        const float sc = __builtin_amdgcn_exp2f(127.0f * l2gamma(hq));
        GAS bf16* op = KV + ((size_t)chh * 128 + eb * 32 + 4 * hi) * 64 + db * 32 + r;
#pragma unroll
        for (int g = 0; g < 4; ++g)
#pragma unroll
            for (int i = 0; i < 4; ++i) op[(size_t)(8 * g + i) * 64] = (bf16)(pk_bf16(acc[4 * g + i] * sc, 0.f) & 0xffffu);
    }
    __syncthreads();
}
__device__ __forceinline__ void ret_item(const bf16* PA_, const bf16* STATE_, bf16* Y_, LAS unsigned char* wl, int b, int n, int h, int qb, int lane) {
    const GAS bf16* PA = (const GAS bf16*)PA_; const GAS bf16* STATE = (const GAS bf16*)STATE_; GAS bf16* Y = (GAS bf16*)Y_;
    const int r = lane & 31, hi = lane >> 5; const size_t row0 = (size_t)b * SEQ + (size_t)n * 128;
    const int laneoff = (4 * hi + ((lane & 15) >> 2)) * 64 + ((lane >> 4) & 1) * 32 + (lane & 3) * 8;
    const int vdst = (lane >> 2) * 64 + (lane & 3) * 16;
    bf16x8 qf[4];
    const size_t ch = (size_t)((b * NCHUNK + n) * 4 + h);
    { const GAS bf16* qp = PA + PA_QR + ch * 8192 + (size_t)(qb * 32 + r) * 32 + hi * 8;
#pragma unroll
      for (int kk = 0; kk < 4; ++kk) qf[kk] = *(const GAS bf16x8*)(qp + (kk >> 1) * 4096 + (kk & 1) * 16); }
    const GAS bf16* vsrc = PA + PA_VR + ch * 16384 + lane * 8;
    const GAS bf16* sp = STATE + (((size_t)(b * NCHUNK + n) * 4 + h) * 128 + r) * 64 + hi * 8;
    u32x4 vst[8]; bf16x8 sf[2][4];
#pragma unroll
    for (int i = 0; i < 8; ++i) vst[i] = *(const GAS u32x4*)(vsrc + i * 512);
#pragma unroll
    for (int kk = 0; kk < 4; ++kk) sf[0][kk] = *(const GAS bf16x8*)(sp + 16 * kk);
    bf16x8 pf[4][2];
#pragma unroll
    for (int kb = 0; kb < 4; ++kb) {
        f32x16 p = {};
        if (kb <= qb) {
            const GAS bf16* kp = PA + PA_KR + ch * 8192 + (size_t)(kb * 32 + r) * 32 + hi * 8;
#pragma unroll
            for (int kk = 0; kk < 4; ++kk) p = __builtin_amdgcn_mfma_f32_32x32x16_bf16(*(const GAS bf16x8*)(kp + (kk >> 1) * 4096 + (kk & 1) * 16), qf[kk], p, 0, 0, 0);
            if (kb == qb) {
#pragma unroll
                for (int reg = 0; reg < 16; ++reg) p[reg] = ((reg & 3) + 8 * (reg >> 2) + 4 * hi <= r) ? p[reg] : 0.f;
            }
        }
        pf[kb][0] = accfrag(p, 0); pf[kb][1] = accfrag(p, 1);
    }
    const float gam = __builtin_amdgcn_exp2f(l2gamma(h));
    f32x16 o[4];
#pragma unroll
    for (int eb = 0; eb < 4; ++eb) {
        LAS unsigned char* img = wl + (eb & 1) * 8192;
#pragma unroll
        for (int i = 0; i < 8; ++i) *(LAS u32x4*)(img + i * 1024 + lane * 16) = vst[i];
        if (eb < 3) {
#pragma unroll
            for (int i = 0; i < 8; ++i) vst[i] = *(const GAS u32x4*)(vsrc + (eb + 1) * 4096 + i * 512);
#pragma unroll
            for (int kk = 0; kk < 4; ++kk) sf[(eb + 1) & 1][kk] = *(const GAS bf16x8*)(sp + (size_t)(eb + 1) * 32 * 64 + 16 * kk);
        }
        asm volatile("" ::: "memory");
        f32x16 a = {};
#pragma unroll
        for (int kk = 0; kk < 4; ++kk) a = __builtin_amdgcn_mfma_f32_32x32x16_bf16(sf[eb & 1][kk], qf[kk], a, 0, 0, 0);
        a = a * gam;
#pragma unroll
        for (int kb = 0; kb < 4; ++kb) if (kb <= qb) {
            a = __builtin_amdgcn_mfma_f32_32x32x16_bf16(trfrag(img, 2 * kb, laneoff), pf[kb][0], a, 0, 0, 0);
            a = __builtin_amdgcn_mfma_f32_32x32x16_bf16(trfrag(img, 2 * kb + 1, laneoff), pf[kb][1], a, 0, 0, 0); }
        o[eb] = a;
    }
    asm volatile("" ::: "memory");
    float ss = 0.f;
#pragma unroll
    for (int eb = 0; eb < 4; ++eb)
#pragma unroll
        for (int reg = 0; reg < 16; ++reg) ss += o[eb][reg] * o[eb][reg];
    ss += xhalf(ss);
    const float rn = __builtin_amdgcn_rsqf(ss * (1.0f / 128.0f) + 1e-6f);
    const GAS bf16* gp = PA + PA_GR + ch * 16384 + (size_t)(qb * 32 + r) * 32 + 4 * hi;
    GAS bf16* yp = Y + (row0 + qb * 32 + r) * 1024 + Y_RET + h * 128 + 4 * hi;
#pragma unroll
    for (int eb = 0; eb < 4; ++eb)
#pragma unroll
        for (int g = 0; g < 4; ++g) { const u32x2 gv = *(const GAS u32x2*)(gp + eb * 4096 + 8 * g);
            *(GAS u32x2*)(yp + eb * 32 + 8 * g) = (u32x2){pk_bf16(o[eb][4 * g] * rn * bf_lo(gv[0]), o[eb][4 * g + 1] * rn * bf_hi(gv[0])), pk_bf16(o[eb][4 * g + 2] * rn * bf_lo(gv[1]), o[eb][4 * g + 3] * rn * bf_hi(gv[1]))}; }
}

__device__ __forceinline__ void ret_group(const bf16* PA_, const bf16* STATE_, bf16* Y_, LAS unsigned char* lds, int cp, int wave, int lane) {
    const GAS bf16* PA = (const GAS bf16*)PA_; const GAS bf16* STATE = (const GAS bf16*)STATE_; GAS bf16* Y = (GAS bf16*)Y_;
    const int grp = wave >> 2, qb = wave & 3, r = lane & 31, hi = lane >> 5;
    const int chh = cp * 2 + grp, h = chh & 3, cn = chh >> 2;
    const size_t ch = (size_t)chh; const size_t row0 = (size_t)cn * 128;
    const int laneoff = (4 * hi + ((lane & 15) >> 2)) * 64 + ((lane >> 4) & 1) * 32 + (lane & 3) * 8;
    LAS unsigned char* gl = lds + grp * 49152;
    __syncthreads();
    { const bf16* vb = (const bf16*)PA_ + PA_VR + ch * 16384 + lane * 8;
#pragma unroll
      for (int j = 0; j < 8; ++j) { const int jj = qb * 8 + j; __builtin_amdgcn_global_load_lds((const unsigned*)(vb + jj * 512), (LAS unsigned*)(gl + jj * 1024), 16, 0, 0); }
      const bf16* sb = (const bf16*)STATE_ + ch * 8192;
#pragma unroll
      for (int j = 0; j < 4; ++j) { const int jj = qb * 4 + j, row = jj * 8 + (lane >> 3), p = (lane & 7) ^ (row & 7);
          __builtin_amdgcn_global_load_lds((const unsigned*)(sb + row * 64 + p * 8), (LAS unsigned*)(gl + 32768 + jj * 1024), 16, 0, 0); } }
    bf16x8 qf[4];
    { const GAS bf16* qp = PA + PA_QR + ch * 8192 + (size_t)(qb * 32 + r) * 32 + hi * 8;
#pragma unroll
      for (int kk = 0; kk < 4; ++kk) qf[kk] = *(const GAS bf16x8*)(qp + (kk >> 1) * 4096 + (kk & 1) * 16); }
    bf16x8 kf[4][4];
    { const GAS bf16* kp = PA + PA_KR + ch * 8192 + (size_t)r * 32 + hi * 8;
#pragma unroll
      for (int kb = 0; kb < 4; ++kb) if (kb <= qb) {
#pragma unroll
          for (int kk = 0; kk < 4; ++kk) kf[kb][kk] = *(const GAS bf16x8*)(kp + kb * 1024 + (kk >> 1) * 4096 + (kk & 1) * 16); } }
    bf16x8 pf[4][2];
#pragma unroll
    for (int kb = 0; kb < 4; ++kb) {
        f32x16 p = {};
        if (kb <= qb) {
#pragma unroll
            for (int kk = 0; kk < 4; ++kk) p = __builtin_amdgcn_mfma_f32_32x32x16_bf16(kf[kb][kk], qf[kk], p, 0, 0, 0);
            if (kb == qb) {
#pragma unroll
                for (int reg = 0; reg < 16; ++reg) p[reg] = ((reg & 3) + 8 * (reg >> 2) + 4 * hi <= r) ? p[reg] : 0.f;
            }
        }
        pf[kb][0] = accfrag(p, 0); pf[kb][1] = accfrag(p, 1);
    }
    asm volatile("s_waitcnt vmcnt(0)" ::: "memory"); __syncthreads(); asm volatile("" ::: "memory");
    const float gam = __builtin_amdgcn_exp2f(l2gamma(h));
    f32x16 o[4];
#pragma unroll
    for (int eb = 0; eb < 4; ++eb) {
        const LAS unsigned char* img = gl + eb * 8192; const int row = eb * 32 + r;
        f32x16 a = {};
#pragma unroll
        for (int kk = 0; kk < 4; ++kk) a = __builtin_amdgcn_mfma_f32_32x32x16_bf16(*(const LAS bf16x8*)(gl + 32768 + row * 128 + (((kk * 2 + hi) ^ (row & 7)) * 16)), qf[kk], a, 0, 0, 0);
        a = a * gam;
#pragma unroll
        for (int kb = 0; kb < 4; ++kb) if (kb <= qb) {
            a = __builtin_amdgcn_mfma_f32_32x32x16_bf16(trfrag((LAS const unsigned char*)img, 2 * kb, laneoff), pf[kb][0], a, 0, 0, 0);
            a = __builtin_amdgcn_mfma_f32_32x32x16_bf16(trfrag((LAS const unsigned char*)img, 2 * kb + 1, laneoff), pf[kb][1], a, 0, 0, 0); }
        o[eb] = a;
    }
    asm volatile("" ::: "memory");
    float ss = 0.f;
#pragma unroll
    for (int eb = 0; eb < 4; ++eb)
#pragma unroll
        for (int reg = 0; reg < 16; ++reg) ss += o[eb][reg] * o[eb][reg];
    ss += xhalf(ss);
    const float rn = __builtin_amdgcn_rsqf(ss * (1.0f / 128.0f) + 1e-6f);
    __syncthreads();
    { LAS unsigned char* stg = gl + qb * 12288;
      LAS unsigned char* st = stg + r * 272 + hi * 8;
#pragma unroll
      for (int eb = 0; eb < 4; ++eb)
#pragma unroll
          for (int g = 0; g < 4; ++g) *(LAS u32x2*)(st + eb * 64 + 16 * g) = (u32x2){pk_bf16(o[eb][4 * g] * rn, o[eb][4 * g + 1] * rn), pk_bf16(o[eb][4 * g + 2] * rn, o[eb][4 * g + 3] * rn)};
      asm volatile("" ::: "memory");
      const int pc = lane & 15, rl = lane >> 4;
      const GAS bf16* gp = PA + PA_GR + ch * 16384 + (size_t)(pc >> 2) * 4096 + (size_t)(qb * 32 + rl) * 32 + (pc & 3) * 8;
      GAS bf16* yp = Y + (row0 + qb * 32 + rl) * 1024 + Y_RET + h * 128 + pc * 8;
      u32x4 gv[8];
#pragma unroll
      for (int i = 0; i < 8; ++i) gv[i] = *(const GAS u32x4*)(gp + (size_t)i * 4 * 32);
#pragma unroll
      for (int i = 0; i < 8; ++i) { const u32x4 ov = *(const LAS u32x4*)(stg + (4 * i + rl) * 272 + pc * 16); u32x4 w;
#pragma unroll
          for (int q = 0; q < 4; ++q) w[q] = pk_bf16(bf_lo(ov[q]) * bf_lo(gv[i][q]), bf_hi(ov[q]) * bf_hi(gv[i][q]));
          *(GAS u32x4*)(yp + (size_t)i * 4 * 1024) = w; }
      asm volatile("" ::: "memory"); }
}

template <int W> __device__ __forceinline__ void pool_run(const bf16* PA_, bf16* Y_, int g, int rbg, int lane) {
    const GAS bf16* PA = (const GAS bf16*)PA_; GAS bf16* Y = (GAS bf16*)Y_;
    const int c8 = lane & 7, row0 = (rbg * 8 + (lane >> 3)) * 8, t0 = row0 & (SEQ - 1);
    const GAS bf16* up = PA + PA_UP + (size_t)row0 * 256 + g * 64 + c8 * 8;
    u32x4 v[W + 7];
#pragma unroll
    for (int j = 0; j < W + 7; ++j) { const int dt = j - (W - 1); v[j] = (t0 + dt >= 0) ? *(const GAS u32x4*)(up + (ptrdiff_t)dt * 256) : (u32x4){0u, 0u, 0u, 0u}; }
    float S[8];
#pragma unroll
    for (int k = 0; k < 8; ++k) S[k] = 0.f;
#pragma unroll
    for (int j = 0; j < W; ++j)
#pragma unroll
        for (int k = 0; k < 4; ++k) { S[2 * k] += bf_lo(v[j][k]); S[2 * k + 1] += bf_hi(v[j][k]); }
    GAS bf16* yp = Y + (size_t)row0 * 1024 + Y_POOL + g * 64 + c8 * 8;
#pragma unroll
    for (int i = 0; i < 8; ++i) {
        if (i > 0) {
#pragma unroll
            for (int k = 0; k < 4; ++k) { S[2 * k] += bf_lo(v[W - 1 + i][k]) - bf_lo(v[i - 1][k]); S[2 * k + 1] += bf_hi(v[W - 1 + i][k]) - bf_hi(v[i - 1][k]); } }
        const int cnt = (t0 + i + 1 < W) ? t0 + i + 1 : W; const float inv = 1.0f / (float)cnt; unsigned o[4];
#pragma unroll
        for (int k = 0; k < 4; ++k) o[k] = pk_bf16(S[2 * k] * inv - bf_lo(v[W - 1 + i][k]), S[2 * k + 1] * inv - bf_hi(v[W - 1 + i][k]));
        *(GAS u32x4*)(yp + (size_t)i * 1024) = (u32x4){o[0], o[1], o[2], o[3]};
    }
}


__device__ __forceinline__ size_t wblk(int n, int k, int nt) { return ((((size_t)(n >> 8) * nt + (k >> 6)) * 2 + ((k >> 5) & 1)) * 256 + (n & 255)) * 32 + (k & 31); }
__device__ __forceinline__ int rho32(int n0) { const int w = n0 & 255; return (n0 & ~255) + ((w >> 5) & 3) * 64 + (w >> 7) * 32; }
__device__ __forceinline__ void tr_item(const float* src_, int ldsrc, int k0, int c0, bf16* dst_, int n0, int nt, int koff, float scale, const float* gain_, LAS float* scr, int lane) {
    const GAS float* src = (const GAS float*)src_; GAS bf16* dst = (GAS bf16*)dst_; const GAS float* gain = (const GAS float*)gain_;
    const int rr = lane >> 3, cc = (lane & 7) * 4;
    f32x4 v[8]; float gk[8];
#pragma unroll
    for (int i = 0; i < 8; ++i) { const int kk = 8 * i + rr; v[i] = *(const GAS f32x4*)(src + (size_t)(k0 + kk) * ldsrc + c0 + cc); gk[i] = gain ? gain[k0 + kk] : 1.0f; }
#pragma unroll
    for (int i = 0; i < 8; ++i) { const int kk = 8 * i + rr; const float s = scale * gk[i]; LAS float* p = scr + kk * 33 + cc; p[0] = v[i][0] * s; p[1] = v[i][1] * s; p[2] = v[i][2] * s; p[3] = v[i][3] * s; }
    asm volatile("s_waitcnt lgkmcnt(0)" ::: "memory");
    const int c = lane & 7;
#pragma unroll
    for (int j = 0; j < 4; ++j) { const int n = (lane >> 3) + 8 * j; const LAS float* s = scr + (8 * c) * 33 + n;
        const u32x4 o = {pk_bf16(s[0 * 33], s[1 * 33]), pk_bf16(s[2 * 33], s[3 * 33]), pk_bf16(s[4 * 33], s[5 * 33]), pk_bf16(s[6 * 33], s[7 * 33])};
        *(GAS u32x4*)(dst + wblk(n0 + n, koff + k0 + 8 * c, nt)) = o; }
    asm volatile("s_waitcnt lgkmcnt(0)" ::: "memory");
}
__device__ __forceinline__ void convert_weights(const LAS unsigned long long* PTAB, int l, unsigned char* wsw, LAS float* scr, int gw, int NGW, int gt, int NT, int lane) {
    bf16* W13A = (bf16*)(wsw + W_13A); bf16* W2A = (bf16*)(wsw + W_2A); bf16* WIN = (bf16*)(wsw + W_IN); bf16* WB = (bf16*)(wsw + W_B); bf16* WOUT = (bf16*)(wsw + W_OUT); bf16* W13B = (bf16*)(wsw + W_13B); bf16* W2B = (bf16*)(wsw + W_2B);
    constexpr int I_13 = 16 * 176, I_2 = 44 * 32, I_IN = 16 * 176, I_SB = 4 * 32, I_RET = 8 * 32, I_OUT = 16 * 32;
    constexpr int NITEMS = 2 * I_13 + 2 * I_2 + I_IN + I_SB + I_RET + I_OUT;
    for (int it = gw; it < NITEMS; it += NGW) {
        int q = it;
        if (q < 2 * I_13) {
            const bool second = q >= I_13; if (second) q -= I_13;
            const int kb = q / 176, nb = q % 176, n0 = 32 * nb, pn = n0 >> 8, bj = (n0 >> 7) & 1, j0 = n0 & 127;
            const float* src = second ? (bj ? (((const float*)PTAB[15]) + (size_t)l * DM * DFF) : (((const float*)PTAB[14]) + (size_t)l * DM * DFF)) : (bj ? (((const float*)PTAB[3]) + (size_t)l * DM * DFF) : (((const float*)PTAB[2]) + (size_t)l * DM * DFF));
            tr_item(src, DFF, 64 * kb, 128 * pn + j0, (second ? W13B : W13A), n0, 16, 0, 1.0f, second ? (((const float*)PTAB[13]) + (size_t)l * DM) : (((const float*)PTAB[1]) + (size_t)l * DM), scr, lane); continue; }
        q -= 2 * I_13;
        if (q < 2 * I_2) {
            const bool second = q >= I_2; if (second) q -= I_2;
            const int kb = q / 32, nb = q % 32;
            tr_item(second ? (((const float*)PTAB[16]) + (size_t)l * DFF * DM) : (((const float*)PTAB[4]) + (size_t)l * DFF * DM), 1024, 64 * kb, rho32(32 * nb), (second ? W2B : W2A), 32 * nb, 44, 0, 0.5f, nullptr, scr, lane); continue; }
        q -= 2 * I_2;
        if (q < I_IN) {
            const int kb = q / 176, nb = q % 176, n0 = 32 * nb; int c0 = n0; float sc = 1.0f;
            if (n0 >= 768 && n0 < 1280) { const int T = n0 >> 8, wi = n0 & 255, bj = wi >> 7, hd = (wi >> 5) & 3; c0 = T * 256 + 64 * hd + 32 * bj; }
            if (n0 >= 2560) c0 = 2560 + rho32(n0 - 2560);
            if (n0 < 256) sc = 0.125f * 1.4426950408889634f; else if (n0 >= 1024 && n0 < 1280) sc = 0.125f; else if (n0 >= 2560) sc = -1.4426950408889634f;
            tr_item((((const float*)PTAB[6]) + (size_t)l * DM * DIN), DIN, 64 * kb, c0, WIN, n0, 16, 0, sc, (((const float*)PTAB[5]) + (size_t)l * DM), scr, lane); continue; }
        q -= I_IN;
        if (q < I_SB) { const int kb = q / 32, nb = q % 32; tr_item((((const float*)PTAB[7]) + (size_t)l * 256 * DM), 1024, 64 * kb, rho32(32 * nb), WB, 32 * nb, 16, Y_SB, 1.0f, nullptr, scr, lane); continue; }
        q -= I_SB;
        if (q < I_RET) { const int kb = q / 32, nb = q % 32; tr_item((((const float*)PTAB[8]) + (size_t)l * 512 * DM), 1024, 64 * kb, rho32(32 * nb), WB, 32 * nb, 16, Y_RET, 1.0f, nullptr, scr, lane); continue; }
        q -= I_RET;
        { const int kb = q / 32, nb = q % 32; tr_item((((const float*)PTAB[12]) + (size_t)l * DM * DM), 1024, 64 * kb, rho32(32 * nb), WOUT, 32 * nb, 16, 0, 1.0f, nullptr, scr, lane); }
    }
    {
        typedef const __attribute__((address_space(4))) float* cfp;
        for (int idx = gt; idx < 256 * 1024; idx += NT) {
            const int n = idx & 1023, kc = __builtin_amdgcn_readfirstlane(idx >> 10), g = kc >> 6;
            const GAS float* bp = (const GAS float*)(((const float*)PTAB[9]) + (size_t)l * 256 * DM) + (size_t)(g * 64) * 1024 + rho32(n & ~31) + (n & 31);
            cfp ap = (cfp)(((const float*)PTAB[10]) + (size_t)l * 4 * 64 * 64 + (size_t)kc * 64); cfp sp = (cfp)(((const float*)PTAB[11]) + (size_t)l * 256 + g * 64);
            float b[64];
#pragma unroll
            for (int e = 0; e < 64; ++e) b[e] = bp[(size_t)e * 1024];
            float s = 0.f;
#pragma unroll
            for (int e = 0; e < 64; ++e) s += ap[e] * sp[e] * b[e];
            ((GAS bf16*)WB)[wblk(n, Y_POOL + kc, 16)] = (bf16)(pk_bf16(s, 0.f) & 0xffffu);
        }
    }
}
__device__ const double c_invf[32] = {1.0, 0.7498942093324559, 0.5623413251903491, 0.4216965034285822, 0.31622776601683794, 0.23713737056616552, 0.1778279410038923, 0.1333521432163324, 0.1, 0.07498942093324558, 0.05623413251903491, 0.042169650342858224, 0.03162277660168379, 0.023713737056616554, 0.01778279410038923, 0.01333521432163324, 0.01, 0.007498942093324558, 0.005623413251903491, 0.004216965034285823, 0.0031622776601683794, 0.0023713737056616554, 0.0017782794100389228, 0.001333521432163324, 0.001, 0.0007498942093324559, 0.0005623413251903491, 0.00042169650342858224, 0.00031622776601683794, 0.00023713737056616554, 0.00017782794100389227, 0.0001333521432163324};
__device__ __forceinline__ void rope_entry(int pos, int i, float* out) {
    const double* invp = c_invf; asm volatile("" : "+v"(invp));
    const double a = (double)pos * invp[i];
    const double n = __builtin_rint(a * 0.63661977236758134308);
    double y = __builtin_fma(-n, 1.57079632673412561417e+00, a); y = __builtin_fma(-n, 6.07710050650619224932e-11, y);
    const double y2 = y * y;
    const double sp = y * (1.0 + y2 * (-1.0 / 6.0 + y2 * (1.0 / 120.0 + y2 * (-1.0 / 5040.0 + y2 * (1.0 / 362880.0 + y2 * (-1.0 / 39916800.0 + y2 * (1.0 / 6227020800.0)))))));
    const double cp = 1.0 + y2 * (-0.5 + y2 * (1.0 / 24.0 + y2 * (-1.0 / 720.0 + y2 * (1.0 / 40320.0 + y2 * (-1.0 / 3628800.0 + y2 * (1.0 / 479001600.0 + y2 * (-1.0 / 87178291200.0)))))));
    const int q = ((int)n) & 3;
    const double s = (q == 0) ? sp : (q == 1) ? cp : (q == 2) ? -sp : -cp, c = (q == 0) ? cp : (q == 1) ? -sp : (q == 2) ? -cp : sp;
    out[0] = (float)c; out[1] = (float)s;
}

#ifndef MK_IP_PROBE
#define MK_IP_PROBE 0
#endif
#ifndef MK_UP_PROBE
#define MK_UP_PROBE 0
#endif
#ifndef MK_NULL_MASK
#define MK_NULL_MASK 0
#endif
#ifndef MK_DOUBLE_MASK
#define MK_DOUBLE_MASK 0
#endif
#ifndef MK_P4_SB_REPS
#define MK_P4_SB_REPS 1
#endif
#ifndef MK_P4_SB_FORCE
#define MK_P4_SB_FORCE 0
#endif
#ifndef MK_P4_KV_REPS
#define MK_P4_KV_REPS 1
#endif
#ifndef MK_SCAN_DEPTH
#define MK_SCAN_DEPTH 128
#endif
#ifndef MK_P4_REPS
#define MK_P4_REPS 1
#endif
#ifndef MK_P4_STAGGER
#define MK_P4_STAGGER 0
#endif
#ifndef MK_P5_REPS
#define MK_P5_REPS 1
#endif
#ifndef MK_P6_REPS
#define MK_P6_REPS 1
#endif
constexpr int PH_PER_LAYER = 11, N_PHASES = DEPTH * PH_PER_LAYER + 1;
struct Args { const float* in[18]; float* out; unsigned char* ws; int ph_lo, ph_hi; };
__global__ void __launch_bounds__(NWAVES * 64, 2) mk_fwd(Args args) {
    extern __shared__ __attribute__((aligned(16))) unsigned char lds_raw[];
    LAS unsigned char* lds = (LAS unsigned char*)lds_raw;
    volatile LAS unsigned* MISC = (volatile LAS unsigned*)(lds + MISC_OFF);
    const int tid0 = threadIdx.x, wave = __builtin_amdgcn_readfirstlane(tid0 >> 6);
    const int G = gridDim.x; const int vcu = (G % 8 == 0) ? ((int)blockIdx.x % 8) * (G / 8) + (int)blockIdx.x / 8 : (int)blockIdx.x;
    const int gw = vcu * NWAVES + wave, NGW = G * NWAVES, NT = G * NWAVES * 64;
    unsigned char* const ws0 = args.ws;
#define SSQ ((float*)(ws + WS_SSQ))
#define ROPE ((float*)(ws + WS_ROPE))
#define XB ((bf16*)(ws + WS_XB))
#define Y ((bf16*)xout)
#define PA ((bf16*)(ws + WS_PA))
#define PG ((bf16*)(ws + WS_PG))
#define ACT ((bf16*)(ws + WS_ACT))
#define MRG ((bf16*)(ws + WS_MRG))
#define KV ((float*)(ws + WS_KV))
#define STATE ((bf16*)(ws + WS_STATE))
#define wsw (ws + WS_W)
    LAS unsigned char* wl = lds + wave * 16384;
    for (int u = tid0; u < 32; u += NWAVES * 64) MISC[u] = 0u;
    LAS unsigned long long* PTAB = (LAS unsigned long long*)(lds + MISC_OFF + 128);
    if (tid0 < 18) PTAB[tid0] = ((const __attribute__((address_space(4))) unsigned long long*)__builtin_amdgcn_kernarg_segment_ptr())[tid0];
    __syncthreads();
    const int lo = args.ph_lo, hi = args.ph_hi;
    XcdBarrier bar; bar.bar = (unsigned*)(ws0 + WS_CTL); bar.x = 0; bar.st = nullptr;
    if (hi - lo > 1) bar = xcd_barrier_post((unsigned*)(ws0 + WS_CTL), MISC + 8);
#define IN(k) (lo <= (k) && (k) < hi)
#ifdef MK_DOUBLE_BARRIER
#define SEAM(k) do { if (IN(k) && IN((k) + 1)) { xcd_barrier(bar); xcd_barrier(bar); } } while (0)
#else
#define SEAM(k) do { if (IN(k) && IN((k) + 1)) xcd_barrier(bar); } while (0)
#endif

    if (IN(0)) {
        unsigned char* ws = ws0; float* xout = args.out; int tid = tid0; asm volatile("" : "+s"(ws), "+s"(xout), "+v"(tid)); const int lane = tid & 63, gt = vcu * (NWAVES * 64) + tid;
                const float* xin = (const float*)PTAB[0];
            for (int row = gw; row < M; row += NGW) {
                const f32x4* xr = (const f32x4*)(xin + (size_t)row * DM) + lane; u32x2* bo = (u32x2*)(XB + (size_t)row * DM) + lane;
                float ss = 0.f;
#pragma unroll
                for (int j = 0; j < 4; ++j) { const f32x4 v = xr[64 * j]; bo[64 * j] = (u32x2){pk_bf16(v[0], v[1]), pk_bf16(v[2], v[3])}; ss += (v[0] * v[0] + v[1] * v[1]) + (v[2] * v[2] + v[3] * v[3]); }
                ss = wave_sum(ss);
                if (lane == 0) *(f32x4*)(SSQ + (size_t)row * 4) = (f32x4){ss, 0.f, 0.f, 0.f};
            }
            for (int idx = gt; idx < SEQ * 32; idx += NT) { const int i = idx & 31; rope_entry(idx >> 5, i, ROPE + ((size_t)(idx & ~31) + ((i >> 1) & 3) * 8 + (i >> 3) * 2 + (i & 1)) * 2); }
            }
    for (int l = 0; l < DEPTH; ++l) {
        const int pb = l * PH_PER_LAYER;
        if (IN(pb + 0)) for (int rep_ = 0; rep_ < (((MK_DOUBLE_MASK >> 0) & 1) ? 2 : 1); ++rep_) {
            unsigned char* ws = ws0; float* xout = args.out; int tid = tid0; asm volatile("" : "+s"(ws), "+s"(xout), "+v"(tid)); const int lane = tid & 63, gt = vcu * (NWAVES * 64) + tid; (void)lane; (void)gt;
            convert_weights(PTAB, l, ws + WS_W, (LAS float*)wl, gw, NGW, gt, NT, lane);
        }
        SEAM(pb + 0);
        if (IN(pb + 1)) for (int rep_ = 0; rep_ < (((MK_DOUBLE_MASK >> 1) & 1) ? 2 : 1); ++rep_) {
            unsigned char* ws = ws0; float* xout = args.out; int tid = tid0; asm volatile("" : "+s"(ws), "+s"(xout), "+v"(tid)); const int lane = tid & 63, gt = vcu * (NWAVES * 64) + tid; (void)lane; (void)gt;
            pg8::Gemm g{XB, (const bf16*)(wsw + W_13A), M, DIN, DM}; pg8::StaticOrder S; S.init(M, DIN, G, (int)blockIdx.x);
            pg8::EpiUp E{ACT, SSQ, (LAS float*)(lds + PSTAT_OFF)};
#if MK_UP_PROBE
            { pg8::EpiUpT<MK_UP_PROBE> EP{ACT, SSQ, (LAS float*)(lds + PSTAT_OFF)}; pg8::gemm_phase<pg8::EpiUpT<MK_UP_PROBE>, pg8::StaticOrder, true, true>(lds, g, S, EP); }
#endif
            if ((MK_NULL_MASK >> 1) & 1) { pg8::EpiNull EN; pg8::gemm_phase<pg8::EpiNull, pg8::StaticOrder, true, true>(lds, g, S, EN); }
            pg8::gemm_phase<pg8::EpiUp, pg8::StaticOrder, true, true>(lds, g, S, E);
        }
        SEAM(pb + 1);
        if (IN(pb + 2)) for (int rep_ = 0; rep_ < (((MK_DOUBLE_MASK >> 2) & 1) ? 2 : 1); ++rep_) {
            unsigned char* ws = ws0; float* xout = args.out; int tid = tid0; asm volatile("" : "+s"(ws), "+s"(xout), "+v"(tid)); const int lane = tid & 63, gt = vcu * (NWAVES * 64) + tid; (void)lane; (void)gt;
            pg8::Gemm g{ACT, (const bf16*)(wsw + W_2A), M, DM, DFF}; pg8::StaticOrder S; S.init(M, DM, G, (int)blockIdx.x);
            if (l == 0) { pg8::EpiResid<true> E{(const void*)PTAB[0], XB, SSQ, (LAS float*)(lds + PSTAT_OFF)};
                pg8::gemm_phase<pg8::EpiResid<true>, pg8::StaticOrder, true, true, true>(lds, g, S, E); }
            else { pg8::EpiResid<false> E{XB, XB, SSQ, (LAS float*)(lds + PSTAT_OFF)};
                pg8::gemm_phase<pg8::EpiResid<false>, pg8::StaticOrder, true, true, true>(lds, g, S, E); }
        }
        SEAM(pb + 2);
        if (IN(pb + 3)) for (int rep_ = 0; rep_ < (((MK_DOUBLE_MASK >> 3) & 1) ? 2 : 1); ++rep_) {
            unsigned char* ws = ws0; float* xout = args.out; int tid = tid0; asm volatile("" : "+s"(ws), "+s"(xout), "+v"(tid)); const int lane = tid & 63, gt = vcu * (NWAVES * 64) + tid; (void)lane; (void)gt;
            pg8::Gemm g{XB, (const bf16*)(wsw + W_IN), M, DIN, DM}; pg8::StaticOrder S; S.init(M, DIN, G, (int)blockIdx.x);
            pg8::EpiInProj E{PA, PG, SSQ, ROPE, (LAS float*)(lds + PSTAT_OFF)};
#if MK_IP_PROBE
            { pg8::EpiInProjT<MK_IP_PROBE> EP{PA, PG, SSQ, ROPE, (LAS float*)(lds + PSTAT_OFF)}; pg8::gemm_phase<pg8::EpiInProjT<MK_IP_PROBE>, pg8::StaticOrder, true, true>(lds, g, S, EP); }
#endif
            if ((MK_NULL_MASK >> 3) & 1) { pg8::EpiNull EN; pg8::gemm_phase<pg8::EpiNull, pg8::StaticOrder, true, true>(lds, g, S, EN); }
            pg8::gemm_phase<pg8::EpiInProj, pg8::StaticOrder, true, true>(lds, g, S, E);
        }
        SEAM(pb + 3);
        if (IN(pb + 4)) for (int rep_ = 0; rep_ < (((MK_DOUBLE_MASK >> 4) & 1) ? 2 : 1); ++rep_) {
            unsigned char* ws = ws0; float* xout = args.out; int tid = tid0; asm volatile("" : "+s"(ws), "+s"(xout), "+v"(tid)); const int lane = tid & 63, gt = vcu * (NWAVES * 64) + tid; (void)lane; (void)gt;
            for (int rp4_ = 0; rp4_ < MK_P4_REPS; ++rp4_) {
                for (int r4_ = 0; r4_ < MK_P4_SB_REPS; ++r4_) for (int it = gw; it < BATCH * 4 * (SEQ / 32); it += NGW) sb_item(PA, Y, wl, it >> 11, (it >> 9) & 3, it & 511, lane, r4_ + 1 < MK_P4_SB_REPS ? MK_P4_SB_FORCE : 0);
                for (int r4_ = 0; r4_ < MK_P4_KV_REPS; ++r4_) kv_group(PA, KV, lds, vcu, G, wave, lane);
            }
        }
        SEAM(pb + 4);
        if (IN(pb + 5)) for (int rep_ = 0; rep_ < MK_P5_REPS * ((((MK_DOUBLE_MASK >> 5) & 1) ? 2 : 1)); ++rep_) {
            unsigned char* ws = ws0; float* xout = args.out; int tid = tid0; asm volatile("" : "+s"(ws), "+s"(xout), "+v"(tid)); const int lane = tid & 63, gt = vcu * (NWAVES * 64) + tid; (void)lane; (void)gt;
            for (int el = gt; el < BATCH * 4 * 4096; el += NT) {
                const int b = el >> 14, h = (el >> 12) & 3, ed = (el & 4095) * 2;
                const float dk = __builtin_amdgcn_exp2f(128.0f * l2gamma(h));
                const size_t base = ((size_t)(b * NCHUNK) * 4 + h) * 8192 + ed;
                float S0 = 0.f, S1 = 0.f;
                const GAS unsigned* kvp = (const GAS unsigned*)((const GAS bf16*)KV + base); GAS unsigned* stp = (GAS unsigned*)((GAS bf16*)STATE + base);
#pragma unroll 1
                for (int n0 = 0; n0 < NCHUNK; n0 += MK_SCAN_DEPTH) { unsigned v[MK_SCAN_DEPTH];
#pragma unroll
                    for (int j = 0; j < MK_SCAN_DEPTH; ++j) v[j] = kvp[(size_t)(n0 + j) * 16384];
#pragma unroll
                    for (int j = 0; j < MK_SCAN_DEPTH; ++j) { stp[(size_t)(n0 + j) * 16384] = pk_bf16(S0, S1); S0 = S0 * dk + bf_lo(v[j]); S1 = S1 * dk + bf_hi(v[j]); } }
            }
            if (gw >= NGW / 4) for (int wi = gw - NGW / 4; wi < 4 * (M / 64); wi += NGW - NGW / 4) { const int g = wi & 3, rbg = wi >> 2;
              { if (g == 0) pool_run<2>(PA, Y, 0, rbg, lane); else if (g == 1) pool_run<4>(PA, Y, 1, rbg, lane); else if (g == 2) pool_run<8>(PA, Y, 2, rbg, lane); else pool_run<16>(PA, Y, 3, rbg, lane); } }
        }
        SEAM(pb + 5);
        if (IN(pb + 6)) for (int rep_ = 0; rep_ < (((MK_DOUBLE_MASK >> 6) & 1) ? 2 : 1); ++rep_) {
            unsigned char* ws = ws0; float* xout = args.out; int tid = tid0; asm volatile("" : "+s"(ws), "+s"(xout), "+v"(tid)); const int lane = tid & 63, gt = vcu * (NWAVES * 64) + tid; (void)lane; (void)gt;
            for (int r6_ = 0; r6_ < MK_P6_REPS; ++r6_) for (int cp = vcu; cp < BATCH * NCHUNK * 4 / 2; cp += G) ret_group(PA, STATE, Y, lds, cp, wave, lane);
        }
        SEAM(pb + 6);
        if (IN(pb + 7)) for (int rep_ = 0; rep_ < (((MK_DOUBLE_MASK >> 7) & 1) ? 2 : 1); ++rep_) {
            unsigned char* ws = ws0; float* xout = args.out; int tid = tid0; asm volatile("" : "+s"(ws), "+s"(xout), "+v"(tid)); const int lane = tid & 63, gt = vcu * (NWAVES * 64) + tid; (void)lane; (void)gt;
            pg8::Gemm g{Y, (const bf16*)(wsw + W_B), M, DM, DM}; pg8::StaticOrder S; S.init(M, DM, G, (int)blockIdx.x);
            pg8::EpiMerge E{MRG, PG};
            if ((MK_NULL_MASK >> 7) & 1) { pg8::EpiNull EN; pg8::gemm_phase<pg8::EpiNull, pg8::StaticOrder, true, true>(lds, g, S, EN); }
            pg8::gemm_phase<pg8::EpiMerge, pg8::StaticOrder, true, true>(lds, g, S, E);
        }
        SEAM(pb + 7);
        if (IN(pb + 8)) for (int rep_ = 0; rep_ < (((MK_DOUBLE_MASK >> 8) & 1) ? 2 : 1); ++rep_) {
            unsigned char* ws = ws0; float* xout = args.out; int tid = tid0; asm volatile("" : "+s"(ws), "+s"(xout), "+v"(tid)); const int lane = tid & 63, gt = vcu * (NWAVES * 64) + tid; (void)lane; (void)gt;
            pg8::Gemm g{MRG, (const bf16*)(wsw + W_OUT), M, DM, DM}; pg8::StaticOrder S; S.init(M, DM, G, (int)blockIdx.x);
            pg8::EpiResid<false> E{XB, XB, SSQ, (LAS float*)(lds + PSTAT_OFF)};
            if ((MK_NULL_MASK >> 8) & 1) { pg8::EpiNull EN; pg8::gemm_phase<pg8::EpiNull, pg8::StaticOrder, true, true>(lds, g, S, EN); }
            pg8::gemm_phase<pg8::EpiResid<false>, pg8::StaticOrder, true, true>(lds, g, S, E);
        }
        SEAM(pb + 8);
        if (IN(pb + 9)) for (int rep_ = 0; rep_ < (((MK_DOUBLE_MASK >> 9) & 1) ? 2 : 1); ++rep_) {
            unsigned char* ws = ws0; float* xout = args.out; int tid = tid0; asm volatile("" : "+s"(ws), "+s"(xout), "+v"(tid)); const int lane = tid & 63, gt = vcu * (NWAVES * 64) + tid; (void)lane; (void)gt;
            pg8::Gemm g{XB, (const bf16*)(wsw + W_13B), M, DIN, DM}; pg8::StaticOrder S; S.init(M, DIN, G, (int)blockIdx.x);
            pg8::EpiUp E{ACT, SSQ, (LAS float*)(lds + PSTAT_OFF)};
#if MK_UP_PROBE
            { pg8::EpiUpT<MK_UP_PROBE> EP{ACT, SSQ, (LAS float*)(lds + PSTAT_OFF)}; pg8::gemm_phase<pg8::EpiUpT<MK_UP_PROBE>, pg8::StaticOrder, true, true>(lds, g, S, EP); }
#endif
            if ((MK_NULL_MASK >> 9) & 1) { pg8::EpiNull EN; pg8::gemm_phase<pg8::EpiNull, pg8::StaticOrder, true, true>(lds, g, S, EN); }
            pg8::gemm_phase<pg8::EpiUp, pg8::StaticOrder, true, true>(lds, g, S, E);
        }
        SEAM(pb + 9);
        if (IN(pb + 10)) for (int rep_ = 0; rep_ < (((MK_DOUBLE_MASK >> 10) & 1) ? 2 : 1); ++rep_) {
            unsigned char* ws = ws0; float* xout = args.out; int tid = tid0; asm volatile("" : "+s"(ws), "+s"(xout), "+v"(tid)); const int lane = tid & 63, gt = vcu * (NWAVES * 64) + tid; (void)lane; (void)gt;
            pg8::Gemm g{ACT, (const bf16*)(wsw + W_2B), M, DM, DFF}; pg8::StaticOrder S; S.init(M, DM, G, (int)blockIdx.x);
            pg8::EpiResid<false> E{XB, XB, SSQ, (LAS float*)(lds + PSTAT_OFF)};
            if ((MK_NULL_MASK >> 10) & 1) { pg8::EpiNull EN; pg8::gemm_phase<pg8::EpiNull, pg8::StaticOrder, true, true, true>(lds, g, S, EN); }
            pg8::gemm_phase<pg8::EpiResid<false>, pg8::StaticOrder, true, true, true>(lds, g, S, E);
        }
        SEAM(pb + 10);
    }
#ifdef MK_DUMP_OFF
    if (IN(N_PHASES - 1)) {
        const unsigned char* ws = ws0; float* xout = args.out;
        for (int i = vcu * 512 + tid0; i < M * 1024; i += NT) { const int row = i >> 10, c = i & 1023; float s = 0.f;
            for (int cc = c + MK_DUMP_C0; cc < MK_DUMP_C1; cc += 1024) { const float v_ = MK_DUMP_F32 ? ((const float*)(ws + MK_DUMP_OFF))[(size_t)row * MK_DUMP_W + cc] : bf_lo((unsigned)((const bf16*)(ws + MK_DUMP_OFF))[(size_t)row * MK_DUMP_W + cc]); s += (v_ != v_) ? 1000.f : (__builtin_fabsf(v_) > 1e30f ? 2000.f : v_); }
            xout[i] = s; }
    }
#else
    if (IN(N_PHASES - 1)) {
        unsigned char* ws = ws0; float* xout = args.out; int tid = tid0; asm volatile("" : "+s"(ws), "+s"(xout), "+v"(tid)); const int lane = tid & 63, gt = vcu * (NWAVES * 64) + tid; (void)lane; (void)gt;
        const float* gf = (const float*)PTAB[17];
        for (int row = gw; row < M; row += NGW) {
            const float rs = pg8::row_rs(SSQ, row); f32x4* xo = (f32x4*)(xout + (size_t)row * DM) + lane; const f32x4* gp = (const f32x4*)gf + lane; const u32x2* xb = (const u32x2*)(XB + (size_t)row * DM) + lane;
#pragma unroll
            for (int j = 0; j < 4; ++j) { const u32x2 x = xb[64 * j]; xo[64 * j] = (f32x4){bf_lo(x[0]), bf_hi(x[0]), bf_lo(x[1]), bf_hi(x[1])} * rs * gp[64 * j]; }
        }
    }
#endif
#undef IN
#undef SEAM
#undef SSQ
#undef ROPE
#undef XB
#undef Y
#undef PA
#undef PG
#undef ACT
#undef MRG
#undef KV
#undef STATE
#undef wsw
}

#ifndef MK_PER_PHASE
#define MK_PER_PHASE 0
#endif
extern "C" void kernel_launch(void* const* d_in, const int* in_sizes, int n_in, void* d_out, int out_size, void* d_ws, size_t ws_size, hipStream_t stream) {
    static int grid = 0;
    if (grid == 0) {
        if (n_in != 18 || in_sizes[0] != M * DM || out_size != M * DM || ws_size < WS_END) { fprintf(stderr, "kernel_launch: unexpected shapes (n_in %d, in0 %d, out %d, ws %zu); nothing launched\n", n_in, n_in > 0 ? in_sizes[0] : -1, out_size, ws_size); grid = -1; return; }
        int dev = 0, cus = 0, per_cu = 0;
        if (hipGetDevice(&dev) != hipSuccess || hipDeviceGetAttribute(&cus, hipDeviceAttributeMultiprocessorCount, dev) != hipSuccess) { grid = -1; return; }
        if (hipFuncSetAttribute((const void*)mk_fwd, hipFuncAttributeMaxDynamicSharedMemorySize, LDS_BYTES) != hipSuccess) { fprintf(stderr, "kernel_launch: hipFuncSetAttribute failed\n"); grid = -1; return; }
        if (hipOccupancyMaxActiveBlocksPerMultiprocessor(&per_cu, (const void*)mk_fwd, NWAVES * 64, LDS_BYTES) != hipSuccess || per_cu < 1) fprintf(stderr, "kernel_launch: note: occupancy query says %d\n", per_cu);
        (void)hipGetLastError();
        grid = cus;
    }
    if (grid < 0) return;
    (void)hipMemsetAsync((char*)d_ws + WS_CTL, 0, CTL_ZERO_BYTES, stream);
    Args a{};
    for (int i = 0; i < 18; ++i) a.in[i] = (const float*)d_in[i];
    a.out = (float*)d_out; a.ws = (unsigned char*)d_ws;
#if MK_PER_PHASE
    for (int p = 0; p < N_PHASES; ++p) {
#ifdef MK_STOP_AFTER
        if (p > MK_STOP_AFTER && p != N_PHASES - 1) continue;
#ifdef MK_SKIP_MASK
        if ((MK_SKIP_MASK >> p) & 1) continue;
#endif
#endif
        a.ph_lo = p; a.ph_hi = p + 1; hipLaunchKernelGGL(mk_fwd, dim3(grid), dim3(NWAVES * 64), LDS_BYTES, stream, a); }
#else
    a.ph_lo = 0; a.ph_hi = N_PHASES; hipLaunchKernelGGL(mk_fwd, dim3(grid), dim3(NWAVES * 64), LDS_BYTES, stream, a);
#endif
    const hipError_t le = hipPeekAtLastError();
    if (le != hipSuccess) fprintf(stderr, "kernel_launch: launch failed: %s\n", hipGetErrorName(le));
}
```
